# Optimizing an MI355X kernel written in HIP

```python
import jax
import jax.numpy as jnp
from jax import lax
import numpy as np

D_MODEL = 2048
BATCH = 4
SEQ = 4096
DEPTH = 2

F32 = jnp.float32
GRID_W = 64
CTX_LEN = 256
N_EVEN = (DEPTH + 1) // 2
N_ODD = DEPTH // 2

M_HEADS = 4
M_DIM = D_MODEL // 2
M_HEAD_DIM = M_DIM // M_HEADS
M_CHUNK = 128
M_CONV = 3
P_DIM = D_MODEL - M_DIM
P_GROUPS = 4
P_GROUP_DIM = P_DIM // P_GROUPS
POOL_WINDOWS = (2, 4, 8, 16)
IN_AB = 4 * M_DIM + 4 * M_HEADS + P_DIM
A_HEADS = 16
Q_LORA = 1536
KV_LORA = 512
NOPE = 128
ROPE = 64
V_DIM = 128
IN_C = Q_LORA + KV_LORA + ROPE
ROPE_THETA = 10000.0
Q_BLOCK = 128
N_EXPERTS = 16
EC_FACTOR = 2
F_EXPERT = D_MODEL
LN_EPS = 1e-5
RMS_EPS = 1e-6
ALPHA = (2 * DEPTH) ** 0.25
BETA = (8 * DEPTH) ** -0.25

kernel_name = 'hybrid_mlstm_pool_mla_ec_dit'


def layer_norm(x, g, b):
    xf = x.astype(F32)
    mu = jnp.mean(xf, -1, keepdims=True)
    var = jnp.mean(jnp.square(xf - mu), -1, keepdims=True)
    return ((xf - mu) * lax.rsqrt(var + LN_EPS) * g + b).astype(x.dtype)


def rms_norm(x, g):
    xf = x.astype(F32)
    return (xf * lax.rsqrt(jnp.mean(jnp.square(xf), -1, keepdims=True) + RMS_EPS) * g).astype(x.dtype)


def adaln(cond, w, b):
    m = jax.nn.silu(cond) @ w + b
    m = jnp.expand_dims(m.reshape(cond.shape[:-1] + (6, D_MODEL)), -3)
    return [m[..., k, :] for k in range(6)]


def modulate(x, shift, scale):
    return x * (1.0 + scale) + shift


def post_norm(x, y, gate, g, b):
    return layer_norm(ALPHA * x + (1.0 + gate) * y, g, b)


def depthwise_conv_centred(u, w, b):
    out = lax.conv_general_dilated(u, w[:, None, :].astype(u.dtype), window_strides=(1,),
                                   padding=[(M_CONV // 2, M_CONV // 2)],
                                   dimension_numbers=('NWC', 'WIO', 'NWC'),
                                   feature_group_count=u.shape[-1])
    return out + b


def ab_project(h, w_in, conv_w, conv_b, gate_b):
    p = h @ w_in
    qk = jax.nn.silu(depthwise_conv_centred(p[..., :2 * M_DIM], conv_w, conv_b))
    q = qk[..., :M_DIM]
    k = qk[..., M_DIM:] * (M_HEAD_DIM ** -0.5)
    v = p[..., 2 * M_DIM:3 * M_DIM]
    o = p[..., 3 * M_DIM:4 * M_DIM]
    gates = (p[..., 4 * M_DIM:4 * M_DIM + 4 * M_HEADS].astype(F32) + gate_b).reshape(p.shape[:2] + (2, 2, M_HEADS))
    u = p[..., 4 * M_DIM + 4 * M_HEADS:]
    return q, k, v, o, gates, u


def mlstm_directions(q, k, v, gates):
    def heads(a):
        return a.astype(F32).reshape(a.shape[:2] + (M_HEADS, M_HEAD_DIM)).transpose(0, 2, 1, 3)

    def stack(fwd, bwd):
        return jnp.concatenate([fwd, jnp.flip(bwd, 2)], 0)

    qh, kh, vh = heads(q), heads(k), heads(v)
    li = gates[..., 0, :].transpose(2, 0, 3, 1)
    lf = jax.nn.log_sigmoid(gates[..., 1, :]).transpose(2, 0, 3, 1)
    return stack(qh, qh), stack(kh, kh), stack(vh, vh), stack(li[0], li[1]), stack(lf[0], lf[1])


def mlstm_chunk_scan(q, k, v, li, lf, state):
    N, H, T, _ = q.shape
    nc = T // M_CHUNK

    def chunks(a):
        return jnp.moveaxis(a.reshape(a.shape[:2] + (nc, M_CHUNK) + a.shape[3:]), 2, 0)

    tril = jnp.tril(jnp.ones((M_CHUNK, M_CHUNK), bool))

    def step(carry, xs):
        C, n, m = carry
        qc, kc, vc, lic, lfc = xs
        b = jnp.cumsum(lfc, -1)
        dmat = jnp.where(tril, b[..., :, None] - b[..., None, :] + lic[..., None, :], -jnp.inf)
        inter = b + m[..., None]
        m_t = jnp.maximum(inter, jnp.max(dmat, -1))
        w_intra = jnp.exp(dmat - m_t[..., None])
        w_inter = jnp.exp(inter - m_t)
        s = jnp.einsum('nhtd,nhsd->nhts', qc, kc) * w_intra
        num = w_inter[..., None] * jnp.einsum('nhtd,nhde->nhte', qc, C) + jnp.einsum('nhts,nhse->nhte', s, vc)
        den = w_inter * jnp.einsum('nhtd,nhd->nht', qc, n) + jnp.sum(s, -1)
        h = num / jnp.maximum(jnp.abs(den), jnp.exp(-m_t))[..., None]
        bl = b[..., -1]
        g = bl[..., None] - b + lic
        m_new = jnp.maximum(bl + m, jnp.max(g, -1))
        wg = jnp.exp(g - m_new[..., None])
        decay = jnp.exp(bl + m - m_new)
        C_new = decay[..., None, None] * C + jnp.einsum('nhsd,nhse->nhde', kc * wg[..., None], vc)
        n_new = decay[..., None] * n + jnp.einsum('nhs,nhsd->nhd', wg, kc)
        return (C_new, n_new, m_new), h

    state, hs = lax.scan(step, state, (chunks(q), chunks(k), chunks(v), chunks(li), chunks(lf)))
    h = jnp.moveaxis(hs, 0, 2).reshape(N, H, T, -1)
    return h, state


def mlstm_readout(h2, o, head_g):
    nb = h2.shape[0] // 2
    h = (h2[:nb] + jnp.flip(h2[nb:], 2)).transpose(0, 2, 1, 3)
    mu = jnp.mean(h, -1, keepdims=True)
    var = jnp.mean(jnp.square(h - mu), -1, keepdims=True)
    h = (h - mu) * lax.rsqrt(var + LN_EPS) * head_g.reshape(M_HEADS, M_HEAD_DIM)
    return (h.reshape(h.shape[:2] + (M_DIM,)) * jax.nn.sigmoid(o.astype(F32))).astype(o.dtype)


def pool_mixer(u, pool_w, pool_s):
    nb, T, _ = u.shape
    ug = u.astype(F32).reshape(nb, T, P_GROUPS, P_GROUP_DIM)
    cs = jnp.concatenate([jnp.zeros((nb, 1, P_GROUPS, P_GROUP_DIM), F32), jnp.cumsum(ug, axis=1)], 1)
    t = jnp.arange(T)
    outs = []
    for g, w in enumerate(POOL_WINDOWS):
        lo = jnp.clip(t - w // 2, 0, T)
        hi = jnp.clip(t + w // 2, 0, T)
        csg = cs[:, :, g]
        mean = (csg[:, hi] - csg[:, lo]) / (hi - lo).astype(F32)[:, None]
        outs.append(mean - ug[:, :, g])
    pooled = jnp.stack(outs, 2).astype(u.dtype)
    y = jnp.einsum('btgc,gcd->btgd', pooled, pool_w)
    return y.reshape(u.shape) * pool_s


def mixer_mlstm_pool(h_lat, h_ctx, w_in, conv_w, conv_b, gate_b, head_g, pool_w, pool_s, w_out, with_ctx_out):
    n2 = 2 * h_lat.shape[0]
    state0 = (jnp.zeros((n2, M_HEADS, M_HEAD_DIM, M_HEAD_DIM), F32),
              jnp.zeros((n2, M_HEADS, M_HEAD_DIM), F32),
              jnp.zeros((n2, M_HEADS), F32))
    qc, kc, vc, oc, gc, uc = ab_project(h_ctx, w_in, conv_w, conv_b, gate_b)
    h2_ctx, ctx_state = mlstm_chunk_scan(*mlstm_directions(qc, kc, vc, gc), state0)
    ql, kl, vl, ol, gl, ul = ab_project(h_lat, w_in, conv_w, conv_b, gate_b)
    h2_lat, _ = mlstm_chunk_scan(*mlstm_directions(ql, kl, vl, gl), ctx_state)
    y_lat = jnp.concatenate([mlstm_readout(h2_lat, ol, head_g), pool_mixer(ul, pool_w, pool_s)], -1) @ w_out
    if not with_ctx_out:
        return y_lat, None
    y_ctx = jnp.concatenate([mlstm_readout(h2_ctx, oc, head_g), pool_mixer(uc, pool_w, pool_s)], -1) @ w_out
    return y_lat, y_ctx


def axial_rope_tables(n_tokens):
    rows = n_tokens // GRID_W
    row = jnp.repeat(jnp.arange(rows), GRID_W)
    col = jnp.tile(jnp.arange(GRID_W), rows)
    half = ROPE // 2
    inv = ROPE_THETA ** (-jnp.arange(0, half, 2, dtype=F32) / half)
    ang = jnp.stack([row[:, None] * inv, col[:, None] * inv], 1)
    return jnp.cos(ang), jnp.sin(ang)


def apply_axial_rope(x, cos, sin):
    xs = x.reshape(x.shape[:-1] + (2, 2, ROPE // 4))
    x1, x2 = xs[..., 0, :], xs[..., 1, :]
    out = jnp.stack([x1 * cos - x2 * sin, x2 * cos + x1 * sin], -2)
    return out.reshape(x.shape).astype(x.dtype)


def mla_q(pq, q_norm_g, w_uq):
    q = (rms_norm(pq, q_norm_g) @ w_uq).reshape(pq.shape[:2] + (A_HEADS, NOPE + ROPE))
    return q[..., :NOPE], q[..., NOPE:]


def mla_kv(pkv, kv_norm_g, w_ukv):
    kv = (rms_norm(pkv[..., :KV_LORA], kv_norm_g) @ w_ukv).reshape(pkv.shape[:2] + (A_HEADS, NOPE + V_DIM))
    return kv[..., :NOPE], pkv[..., KV_LORA:], kv[..., NOPE:]


def attend_blocks(q_nope, q_pe, k_nope, k_pe, v):
    nb, tq = q_nope.shape[:2]
    nblk = tq // Q_BLOCK
    scale = (NOPE + ROPE) ** -0.5

    def blk(a):
        return jnp.moveaxis(a.reshape((nb, nblk, Q_BLOCK) + a.shape[2:]), 1, 0)

    def one(args):
        qn, qp = args
        s = (jnp.einsum('bqhd,bkhd->bhqk', qn, k_nope, preferred_element_type=F32)
             + jnp.einsum('bqhr,bkr->bhqk', qp, k_pe, preferred_element_type=F32)) * scale
        p = jax.nn.softmax(s, axis=-1).astype(v.dtype)
        return jnp.einsum('bhqk,bkhd->bqhd', p, v)

    out = lax.map(one, (blk(q_nope), blk(q_pe)))
    return jnp.moveaxis(out, 0, 1).reshape(nb, tq, A_HEADS * V_DIM)


def mixer_mla(h_lat, h_ctx, w_in, q_norm_g, kv_norm_g, w_uq, w_ukv, w_o, with_ctx_out):
    cos, sin = axial_rope_tables(h_lat.shape[1])
    p_lat = h_lat @ w_in
    qn_l, qp_l = mla_q(p_lat[..., :Q_LORA], q_norm_g, w_uq)
    qp_l = apply_axial_rope(qp_l, cos[:, None], sin[:, None])
    kn_l, kp_l, v_l = mla_kv(p_lat[..., Q_LORA:], kv_norm_g, w_ukv)
    kp_l = apply_axial_rope(kp_l, cos, sin)
    p_ctx = h_ctx @ (w_in if with_ctx_out else w_in[:, Q_LORA:])
    kn_c, kp_c, v_c = mla_kv(p_ctx[..., -(KV_LORA + ROPE):], kv_norm_g, w_ukv)
    k_nope = jnp.concatenate([kn_c, kn_l], 1)
    k_pe = jnp.concatenate([kp_c, kp_l], 1)
    v = jnp.concatenate([v_c, v_l], 1)
    y_lat = attend_blocks(qn_l, qp_l, k_nope, k_pe, v) @ w_o
    if not with_ctx_out:
        return y_lat, None
    qn_c, qp_c = mla_q(p_ctx[..., :Q_LORA], q_norm_g, w_uq)
    y_ctx = attend_blocks(qn_c, qp_c, kn_c, kp_c, v_c) @ w_o
    return y_lat, y_ctx


def expert_choice_ffn(h, w_router, w1, w3, w2):
    nb, T, _ = h.shape
    cap = EC_FACTOR * T // N_EXPERTS
    aff = jax.nn.softmax(jnp.einsum('btd,de->bte', h, w_router, preferred_element_type=F32), axis=-1)
    gate, idx = lax.top_k(jnp.swapaxes(aff, 1, 2), cap)
    bidx = jnp.arange(nb)[:, None, None]
    xe = h[bidx, idx]
    a = jnp.einsum('becd,edf->becf', xe, w1)
    g = jnp.einsum('becd,edf->becf', xe, w3)
    y = jnp.einsum('becf,efd->becd', jax.nn.silu(a) * g, w2)
    y = y * gate[..., None].astype(y.dtype)
    return jnp.zeros_like(h).at[bidx, idx].add(y)


def setup_inputs(seed: int = 0) -> dict:
    ks = iter(jax.random.split(jax.random.key(seed), 32))

    def nrm(shape, scale):
        return scale * jax.random.normal(next(ks), shape, F32)

    D = D_MODEL
    ne, no = N_EVEN, N_ODD
    i_b = nrm((ne, 2, 1, M_HEADS), 0.1)
    f_b = jnp.linspace(3.0, 6.0, M_HEADS, dtype=F32) + nrm((ne, 2, 1, M_HEADS), 0.1)
    return {
        'x': nrm((BATCH, SEQ, D), 1.0),
        'c': nrm((BATCH, D), 1.0),
        'ctx': nrm((BATCH, CTX_LEN, D), 1.0),
        'c_ctx': nrm((D,), 1.0),
        'ada_w': nrm((DEPTH, D, 6 * D), 0.5 * D ** -0.5),
        'ada_b': nrm((DEPTH, 6 * D), 0.02),
        'ln_g': 1.0 + nrm((DEPTH, 2, D), 0.05),
        'ln_b': nrm((DEPTH, 2, D), 0.02),
        'ab_w_in': nrm((ne, D, IN_AB), D ** -0.5),
        'ab_conv_w': nrm((ne, M_CONV, 2 * M_DIM), M_CONV ** -0.5),
        'ab_conv_b': nrm((ne, 2 * M_DIM), 0.02),
        'ab_gate_b': jnp.concatenate([i_b, f_b], 2).reshape(ne, 4 * M_HEADS),
        'ab_head_g': 1.0 + nrm((ne, M_DIM), 0.05),
        'ab_pool_w': nrm((ne, P_GROUPS, P_GROUP_DIM, P_GROUP_DIM), P_GROUP_DIM ** -0.5),
        'ab_pool_s': 1.0 + nrm((ne, P_DIM), 0.1),
        'ab_w_out': nrm((ne, M_DIM + P_DIM, D), BETA * (M_DIM + P_DIM) ** -0.5),
        'mla_w_in': nrm((no, D, IN_C), D ** -0.5),
        'mla_q_norm_g': 1.0 + nrm((no, Q_LORA), 0.05),
        'mla_kv_norm_g': 1.0 + nrm((no, KV_LORA), 0.05),
        'mla_w_uq': nrm((no, Q_LORA, A_HEADS * (NOPE + ROPE)), Q_LORA ** -0.5),
        'mla_w_ukv': nrm((no, KV_LORA, A_HEADS * (NOPE + V_DIM)), KV_LORA ** -0.5),
        'mla_w_o': nrm((no, A_HEADS * V_DIM, D), BETA * (A_HEADS * V_DIM) ** -0.5),
        'moe_router': nrm((DEPTH, D, N_EXPERTS), D ** -0.5),
        'moe_w1': nrm((DEPTH, N_EXPERTS, D, F_EXPERT), D ** -0.5),
        'moe_w3': nrm((DEPTH, N_EXPERTS, D, F_EXPERT), D ** -0.5),
        'moe_w2': nrm((DEPTH, N_EXPERTS, F_EXPERT, D), BETA * F_EXPERT ** -0.5),
    }


def reference(x, c, ctx, c_ctx, ada_w, ada_b, ln_g, ln_b, ab_w_in, ab_conv_w, ab_conv_b, ab_gate_b,
              ab_head_g, ab_pool_w, ab_pool_s, ab_w_out, mla_w_in, mla_q_norm_g, mla_kv_norm_g,
              mla_w_uq, mla_w_ukv, mla_w_o, moe_router, moe_w1, moe_w3, moe_w2):
    x_lat, x_ctx = x, ctx
    for i in range(DEPTH):
        with_ctx = i < DEPTH - 1
        j = i // 2
        sh_l, sc_l, ga_l, shf_l, scf_l, gaf_l = adaln(c, ada_w[i], ada_b[i])
        sh_c, sc_c, ga_c, shf_c, scf_c, gaf_c = adaln(c_ctx, ada_w[i], ada_b[i])
        h_lat = modulate(x_lat, sh_l, sc_l)
        h_ctx = modulate(x_ctx, sh_c, sc_c)
        if i % 2 == 0:
            y_lat, y_ctx = mixer_mlstm_pool(h_lat, h_ctx, ab_w_in[j], ab_conv_w[j], ab_conv_b[j], ab_gate_b[j],
                                            ab_head_g[j], ab_pool_w[j], ab_pool_s[j], ab_w_out[j], with_ctx)
        else:
            y_lat, y_ctx = mixer_mla(h_lat, h_ctx, mla_w_in[j], mla_q_norm_g[j], mla_kv_norm_g[j],
                                     mla_w_uq[j], mla_w_ukv[j], mla_w_o[j], with_ctx)
        x_lat = post_norm(x_lat, y_lat, ga_l, ln_g[i, 0], ln_b[i, 0])
        f_lat = expert_choice_ffn(modulate(x_lat, shf_l, scf_l), moe_router[i], moe_w1[i], moe_w3[i], moe_w2[i])
        x_lat = post_norm(x_lat, f_lat, gaf_l, ln_g[i, 1], ln_b[i, 1])
        if with_ctx:
            x_ctx = post_norm(x_ctx, y_ctx, ga_c, ln_g[i, 0], ln_b[i, 0])
            f_ctx = expert_choice_ffn(modulate(x_ctx, shf_c, scf_c), moe_router[i], moe_w1[i], moe_w3[i], moe_w2[i])
            x_ctx = post_norm(x_ctx, f_ctx, gaf_c, ln_g[i, 1], ln_b[i, 1])
    return x_lat
```

```cpp
#include <hip/hip_runtime.h>
#include <cstdio>
#include <cstdint>

#define GAS __attribute__((address_space(1)))
#define LAS __attribute__((address_space(3)))
typedef unsigned short bf16;
typedef unsigned v4u __attribute__((ext_vector_type(4)));
typedef unsigned v2u __attribute__((ext_vector_type(2)));
typedef float f32x4 __attribute__((ext_vector_type(4)));
typedef float f32x2 __attribute__((ext_vector_type(2)));
typedef float f32x16 __attribute__((ext_vector_type(16)));
typedef short bf16x8 __attribute__((ext_vector_type(8)));
typedef short s16x4 __attribute__((ext_vector_type(4)));
typedef GAS unsigned gu32;
#define RLX_AGENT __ATOMIC_RELAXED, __HIP_MEMORY_SCOPE_AGENT
#define LDS_WAIT() asm volatile("s_waitcnt lgkmcnt(0)" ::: "memory")
#define VM_WAIT() asm volatile("s_waitcnt vmcnt(0)" ::: "memory")

constexpr int DM = 2048, NB = 4, SEQ = 4096, CTXL = 256;
constexpr int NL = NB * SEQ;
constexpr int NCX = NB * CTXL;
constexpr int R0 = NL + NCX;
constexpr int MH = 4, MDIM = 1024, MHD = 256, INAB = 5136, PW = 5120;
constexpr int QLORA = 1536, KVLORA = 512, ROPE = 64, NOPE = 128, VD = 128, AH = 16, INC = 2112, PLW = 2304;
constexpr int NE = 16, CAPL = 512, CAPC = 32;
constexpr int SLOTS0 = 2304, SLOTS1 = 2048;
constexpr int KVS = CTXL + SEQ;
constexpr float LN_EPS = 1e-5f, RMS_EPS = 1e-6f;
constexpr float ALPHA = 1.4142135623730951f;

constexpr size_t MiB = 1u << 20;
constexpr size_t WS_CTL = 0, CTL_ZERO_BYTES = 1 * MiB;
constexpr size_t WS_MOD = 1 * MiB;
constexpr size_t WS_AFF = 3 * MiB;
constexpr size_t WS_RIDX = 5 * MiB;
constexpr size_t WS_RGATE = 5 * MiB + 256 * 1024;
constexpr size_t WS_RSLOT = 6 * MiB;
constexpr size_t WS_GATES = 8 * MiB;
constexpr size_t WS_KPE = 10 * MiB;
constexpr size_t WS_ROPE = 13 * MiB;
constexpr size_t WS_WIN0 = 1660 * MiB;
constexpr size_t WS_WOUT0 = 36 * MiB;
constexpr size_t WS_WPOOL = 44 * MiB;
constexpr size_t WS_WMIN = 45 * MiB;
constexpr size_t WS_WUQ = 54 * MiB;
constexpr size_t WS_WUKV = 63 * MiB;
constexpr size_t WS_WO = 67 * MiB;
constexpr size_t WS_WM13 = 76 * MiB;
constexpr size_t WS_WM2 = 588 * MiB;
constexpr size_t WS_X1 = 844 * MiB;
constexpr size_t WS_H = 980 * MiB;
constexpr size_t WS_Y = 1048 * MiB;
constexpr size_t WS_MIX = 1184 * MiB;
constexpr size_t WS_PB = WS_MIX;
constexpr size_t WS_QK = WS_MIX + 170 * MiB;
constexpr size_t WS_PU = WS_MIX + 238 * MiB;
constexpr size_t WS_HF = WS_MIX + 272 * MiB;
constexpr size_t WS_A2 = WS_MIX + 408 * MiB;
constexpr size_t WS_PL = WS_MIX;
constexpr size_t WS_QN = WS_MIX + 77 * MiB;
constexpr size_t WS_KVN = WS_MIX + 125 * MiB;
constexpr size_t WS_QF = WS_MIX + 142 * MiB;
constexpr size_t WS_KV = WS_MIX + 238 * MiB;
constexpr size_t WS_O = WS_MIX + 374 * MiB;
constexpr size_t WS_ACT = WS_MIX;
constexpr size_t WS_YS = WS_MIX + 144 * MiB;
constexpr size_t WS_END = WS_MIX + 476 * MiB + 21 * MiB;
static_assert(WS_QK + (size_t)R0 * 2048 * 2 <= WS_PU && WS_PU + (size_t)R0 * 1024 * 2 <= WS_HF && WS_HF + (size_t)2 * R0 * 1024 * 4 <= WS_A2 && WS_A2 + (size_t)R0 * 2048 * 2 <= WS_END, "mix map 0");
static_assert(WS_PL + (size_t)R0 * PLW * 2 <= WS_QN && WS_QN + (size_t)NL * 1536 * 2 <= WS_KVN && WS_KVN + (size_t)R0 * 512 * 2 <= WS_QF && WS_QF + (size_t)NL * 3072 * 2 <= WS_KV && WS_KV + (size_t)R0 * 4096 * 2 <= WS_O && WS_O + (size_t)NL * 2048 * 2 <= WS_END, "mix map 1");
static_assert(WS_ACT + (size_t)16 * 2304 * 2048 * 2 <= WS_YS && WS_YS + (size_t)16 * 2304 * 2048 * 2 <= WS_END, "mix map moe");
static_assert(WS_PB + (size_t)R0 * PW * 2 <= WS_QK, "pb");

constexpr int CW_TMO = 0, CW_CODE = 1, CW_BAR = 4096;
constexpr int CW_RDY = 16384;

constexpr int LDS_BYTES = 151552;
constexpr int LDSCTL_OFF = 147456, MISC_OFF = LDSCTL_OFF + 320;
constexpr int NWAVES = 8;

__device__ __forceinline__ unsigned f2bf(float f) { unsigned u = __builtin_bit_cast(unsigned, f); return (u + 0x7fffu + ((u >> 16) & 1u)) >> 16; }
__device__ __forceinline__ unsigned pk2(float lo, float hi) { unsigned r; asm("v_cvt_pk_bf16_f32 %0, %1, %2" : "=v"(r) : "v"(lo), "v"(hi)); return r; }
__device__ __forceinline__ float bf2f(unsigned short b) { return __builtin_bit_cast(float, (unsigned)b << 16); }
__device__ __forceinline__ float bflo(unsigned w) { return __builtin_bit_cast(float, w << 16); }
__device__ __forceinline__ float bfhi(unsigned w) { return __builtin_bit_cast(float, w & 0xffff0000u); }
template <int CTRL> __device__ __forceinline__ float dpp_mov(float v) { return __uint_as_float((unsigned)__builtin_amdgcn_update_dpp(0, (int)__float_as_uint(v), CTRL, 0xF, 0xF, true)); }
__device__ __forceinline__ float wave_sum(float v) {
    v += dpp_mov<0xB1>(v);
    v += dpp_mov<0x4E>(v);
    v += dpp_mov<0x141>(v);
    v += dpp_mov<0x140>(v);
    { auto rr = __builtin_amdgcn_permlane16_swap(__float_as_uint(v), __float_as_uint(v), false, false); v = __uint_as_float(rr[0]) + __uint_as_float(rr[1]); }
    { auto rr = __builtin_amdgcn_permlane32_swap(__float_as_uint(v), __float_as_uint(v), false, false); v = __uint_as_float(rr[0]) + __uint_as_float(rr[1]); }
    return v;
}
__device__ __forceinline__ float siluf(float x) { return x / (1.f + __expf(-x)); }
__device__ __forceinline__ float sigmoidf_(float x) { return 1.f / (1.f + __expf(-x)); }

#define XB_TMO      128
#define XB_XCNT(j)  (256  + 64 * (j))
#define XB_XSUB(j)  (1280 + 64 * (j))
#define XB_XGEN(j)  (2304 + 64 * (j))
#define XB_TOP      3328
#define XB_TOPGEN   3392
#define XCD_BAR_WORDS 3456
#define XB_SPIN_CAP (1u << 18)
__device__ __forceinline__ unsigned xb_ld(unsigned* p)              { return __hip_atomic_load(p, __ATOMIC_RELAXED, __HIP_MEMORY_SCOPE_AGENT); }
__device__ __forceinline__ unsigned xb_add(unsigned* p, unsigned v) { return __hip_atomic_fetch_add(p, v, __ATOMIC_RELAXED, __HIP_MEMORY_SCOPE_AGENT); }
__device__ __forceinline__ unsigned xb_xcc_id() { return (unsigned)__builtin_amdgcn_s_getreg((3 << 11) | 20) & 0xFu; }
#define XB_SPIN(cond, bar) do { unsigned _sp = 0; while (cond) { __builtin_amdgcn_s_sleep(1); \
    if ((++_sp & 255u) == 0u) { if (xb_ld(&(bar)[XB_TMO])) break; if (_sp > XB_SPIN_CAP) { atomicAdd(&(bar)[XB_TMO], 1u); break; } } } } while (0)
struct XcdBarrier { unsigned* bar; unsigned x; volatile LAS unsigned* st; };
__device__ __forceinline__ XcdBarrier xcd_barrier_post(unsigned* bar, volatile LAS unsigned* st) {
    XcdBarrier b; b.bar = bar; b.x = xb_xcc_id(); b.st = st;
    if (threadIdx.x == 0) (void)xb_add(&bar[XB_XCNT(b.x)], 1u);
    return b;
}
__device__ __forceinline__ void xcd_barrier_complete(unsigned* bar, unsigned x, unsigned& nloc, unsigned& nx) {
    const unsigned G = gridDim.x * gridDim.y * gridDim.z;
    unsigned sum, cnt, mine, sp = 0u;
    for (;;) {
        sum = 0u; cnt = 0u; mine = 0u;
#pragma unroll
        for (unsigned j = 0; j < 16; ++j) { const unsigned c = xb_ld(&bar[XB_XCNT(j)]); sum += c; cnt += (c > 0u) ? 1u : 0u; mine = (j == x) ? c : mine; }
        if (sum == G) break;
        __builtin_amdgcn_s_sleep(1);
        if ((++sp & 255u) == 0u) { if (xb_ld(&bar[XB_TMO])) break; if (sp > XB_SPIN_CAP) { atomicAdd(&bar[XB_TMO], 1u); break; } }
    }
    nloc = mine > 0u ? mine : 1u; nx = cnt > 0u ? cnt : 1u;
}
__device__ __forceinline__ void xcd_barrier(const XcdBarrier& b) {
    asm volatile("s_waitcnt vmcnt(0)" ::: "memory");
    __syncthreads();
    if (threadIdx.x == 0) {
        unsigned* bar = b.bar;
        __builtin_amdgcn_s_waitcnt(0);
        unsigned nloc = b.st[0], nx = b.st[1];
        if (nloc == 0u) { xcd_barrier_complete(bar, b.x, nloc, nx); b.st[0] = nloc; b.st[1] = nx; }
        const unsigned old = xb_add(&bar[XB_XSUB(b.x)], 1u);
        const unsigned gen = old / nloc;
        if (old + 1u == (gen + 1u) * nloc) {
            __builtin_amdgcn_fence(__ATOMIC_RELEASE, "agent");
            asm volatile("s_waitcnt vmcnt(0)" ::: "memory");
            const unsigned og = xb_add(&bar[XB_TOP], 1u);
            const unsigned tg = og / nx;
            if (og + 1u == (tg + 1u) * nx) xb_add(&bar[XB_TOPGEN], 1u);
            else XB_SPIN(xb_ld(&bar[XB_TOPGEN]) == tg, bar);
            __builtin_amdgcn_fence(__ATOMIC_ACQUIRE, "agent");
            xb_add(&bar[XB_XGEN(b.x)], 1u);
            asm volatile("s_waitcnt vmcnt(0)" ::: "memory");
        } else {
            XB_SPIN(xb_ld(&bar[XB_XGEN(b.x)]) == gen, bar);
            __builtin_amdgcn_fence(__ATOMIC_ACQUIRE, "agent");
            asm volatile("s_waitcnt vmcnt(0)" ::: "memory");
        }
    }
    __syncthreads();
}

namespace pg8 {
#define PG8_LAS __attribute__((address_space(3)))
typedef unsigned short bf16_t;
typedef unsigned u32x4 __attribute__((ext_vector_type(4)));
constexpr int BM = 256, BK = 64, HALF = 128, HTB = HALF * BK * 2, STAGE_BYTES = 8 * HTB, NXCD = 8, WGM = 8;
__host__ __device__ __forceinline__ int lds_byte(int r, int c) { const int st = (r >> 4) * 2 + (c >> 5), rr = r & 15, cc = c & 31, ob = rr * 64 + cc * 2; return st * 1024 + (ob ^ (((ob >> 9) & 1) << 5)); }
__host__ __device__ __forceinline__ void stage_rc(int b, int& R, int& C) { const int st = b / 1024, sb = b % 1024, swz = sb ^ (((sb >> 9) & 1) << 5); R = (st >> 1) * 16 + swz / 64; C = (st & 1) * 32 + (swz % 64) / 2; }
__host__ __device__ __forceinline__ int perm32(int rho) { const int n = rho >> 4, i = rho & 15; return 8 * (i >> 2) + 4 * n + (i & 3); }

struct Unit { int pm, pn, g, skiphi; };
struct Gemm { const bf16_t* A; const bf16_t* Bt; int lda, ldb, K; };
__device__ __forceinline__ unsigned cvt_pk_bf16(float lo, float hi) { unsigned r; asm volatile("v_cvt_pk_bf16_f32 %0, %1, %2" : "=v"(r) : "v"(lo), "v"(hi)); return r; }

__device__ __forceinline__ int xcd_remap(int L, int nwg) { const int q = nwg / NXCD, r = nwg % NXCD, xcd = L % NXCD, off = L / NXCD; return (xcd < r ? xcd * (q + 1) : r * (q + 1) + (xcd - r) * q) + off; }

struct DenseOrder {
    int nM, nN, nwg, G, c, pm0;
    __device__ void init(int nM_, int nN_, int G_, int c_, int pm0_ = 0) { nM = nM_; nN = nN_; nwg = nM * nN; G = G_; c = c_; pm0 = pm0_; }
    __device__ void at(int L, Unit& u) const {
        const int wgid = xcd_remap(L, nwg);
        const int nig = WGM * nN, gid = wgid / nig, fm = gid * WGM, gsz = (nM - fm) < WGM ? (nM - fm) : WGM;
        u.pm = pm0 + fm + ((wgid % nig) % gsz); u.pn = (wgid % nig) / gsz; u.g = 0; u.skiphi = 0;
    }
    __device__ bool next(int i, Unit& u) const { const long L = (long)i * G + c; if (L >= nwg) return false; at((int)L, u); return true; }
    __device__ __forceinline__ unsigned arow(const Unit& u, int r) const { return (unsigned)(u.pm * BM + r); }
    __device__ __forceinline__ unsigned acol2(const Unit&) const { return 0u; }
    __device__ __forceinline__ size_t boff(const Unit& u, int ldb) const { return (size_t)u.pn * BM * ldb; }
};
struct SplitOrder {
    DenseOrder m, t;
    __device__ void init(int nM1, int nM2, int nN, int G, int c) { m.init(nM1, nN, G, c, 0); t.init(nM2, nN, G, c, nM1); }
    __device__ bool next(int i, Unit& u) const { long L = (long)i * m.G + m.c; if (L < m.nwg) { m.at((int)L, u); return true; } L -= m.nwg; if (L >= t.nwg) return false; t.at((int)L, u); return true; }
    __device__ __forceinline__ unsigned arow(const Unit& u, int r) const { return (unsigned)(u.pm * BM + r); }
    __device__ __forceinline__ unsigned acol2(const Unit&) const { return 0u; }
    __device__ __forceinline__ size_t boff(const Unit& u, int ldb) const { return (size_t)u.pn * BM * ldb; }
};

template <class Epi, class Sched, bool ALIGN_EPI = true>
__device__ __forceinline__ void gemm_phase(PG8_LAS unsigned char* lds, const Gemm g, const Sched& S, const Epi& E) {
    int tid = threadIdx.x; asm volatile("" : "+v"(tid));
    const int wid = __builtin_amdgcn_readfirstlane(tid >> 6), lane = tid & 63, wr = wid >> 2, wc = wid & 3, fr = lane & 15, fq = lane >> 4;
    const int K = g.K, nt = K / BK;
    int RA[2]; unsigned CA2[2], voffB[2];
#pragma unroll
    for (int i = 0; i < 2; ++i) { int R, C; stage_rc(tid * 16 + i * 8192, R, C); const int Rb = Epi::PERM ? ((R & ~31) + perm32(R & 31)) : R;
        RA[i] = R; CA2[i] = (unsigned)C * 2u; voffB[i] = (unsigned)(Rb * BK + C) * 2u; }
    const unsigned lda2 = (unsigned)g.lda * 2u;
    const size_t kstep = (size_t)(BK * 2);
    const size_t hstepB = (size_t)HALF * BK * 2, kstepB = (size_t)BM * BK * 2;
    const unsigned ldsw = (unsigned)wid * 1024u;
    const int aoff = lds_byte(wr * 64 + fr, fq * 8), boff = lds_byte(wc * 32 + fr, fq * 8);
#define PG8_SA(b, h) (((b) * 2 + (h)) * HTB)
#define PG8_SB(b, h) ((4 + (b) * 2 + (h)) * HTB)
#define PG8_STAGEB(bufoff, gbase) do { _Pragma("unroll") for (int _i = 0; _i < 2; ++_i) \
        __builtin_amdgcn_global_load_lds((const unsigned*)((const char*)(gbase) + voffB[_i]), (PG8_LAS unsigned*)(lds + (bufoff) + ldsw + _i * 8192), 16, 0, 0); } while (0)
#define PG8_STAGEA(bufoff, kb, off) do { _Pragma("unroll") for (int _i = 0; _i < 2; ++_i) \
        __builtin_amdgcn_global_load_lds((const unsigned*)(Ab + (kb) + (off)[_i]), (PG8_LAS unsigned*)(lds + (bufoff) + ldsw + _i * 8192), 16, 0, 0); } while (0)
#define PG8_LDA(dst, b, h) do { _Pragma("unroll") for (int m = 0; m < 4; ++m) _Pragma("unroll") for (int k = 0; k < 2; ++k) dst[m][k] = *(const PG8_LAS bf16x8*)(lds + PG8_SA(b, h) + aoff + m * 2048 + k * 1024); } while (0)
#define PG8_LDB(dst, b, h) do { _Pragma("unroll") for (int n = 0; n < 2; ++n) _Pragma("unroll") for (int k = 0; k < 2; ++k) dst[n][k] = *(const PG8_LAS bf16x8*)(lds + PG8_SB(b, h) + boff + n * 2048 + k * 1024); } while (0)
#define PG8_MMA(ai, bj, At, Bt) do { __builtin_amdgcn_s_setprio(1); _Pragma("unroll") for (int m = 0; m < 4; ++m) _Pragma("unroll") for (int n = 0; n < 2; ++n) _Pragma("unroll") for (int k = 0; k < 2; ++k) \
        acc[ai][bj][m][n] = __builtin_amdgcn_mfma_f32_16x16x32_bf16(Bt[n][k], At[m][k], acc[ai][bj][m][n], 0, 0, 0); __builtin_amdgcn_s_setprio(0); } while (0)
#define PG8_WAIT_V(n) asm volatile("s_waitcnt vmcnt(" #n ")" ::: "memory")
#define PG8_WAIT_L(n) asm volatile("s_waitcnt lgkmcnt(" #n ")" ::: "memory")
#define PG8_BAR __builtin_amdgcn_s_barrier()
#define PG8_SCHED __builtin_amdgcn_sched_barrier(0)
#define PG8_AOFF(dst, u) do { _Pragma("unroll") for (int _h = 0; _h < 2; ++_h) _Pragma("unroll") for (int _i = 0; _i < 2; ++_i) dst[_h][_i] = S.arow(u, _h * HALF + RA[_i]) * lda2 + CA2[_i] + S.acol2(u); } while (0)
    Unit cur, nxt; int ui = 0;
    if (!S.next(0, cur)) return;
    f32x4 acc[2][2][4][2];
#pragma unroll
    for (int a = 0; a < 2; ++a)
#pragma unroll
        for (int b = 0; b < 2; ++b)
#pragma unroll
            for (int m = 0; m < 4; ++m)
#pragma unroll
                for (int n = 0; n < 2; ++n) acc[a][b][m][n] = (f32x4){0.f, 0.f, 0.f, 0.f};
    bf16x8 At[4][2], B0[2][2], B1[2][2];
    unsigned oAc[2][2], oAn[2][2];
    PG8_AOFF(oAc, cur);
    const char* Ab = (const char*)g.A;
    const char* cB = (const char*)g.Bt + S.boff(cur, g.ldb) * 2;
    PG8_STAGEB(PG8_SB(0, 0), cB); PG8_STAGEB(PG8_SB(0, 1), cB + hstepB); PG8_STAGEA(PG8_SA(0, 0), (size_t)0, oAc[0]); PG8_STAGEA(PG8_SA(0, 1), (size_t)0, oAc[1]);
    if (wr == 1) PG8_BAR;
    PG8_WAIT_V(2); PG8_BAR;
    PG8_STAGEB(PG8_SB(1, 0), cB + kstepB); PG8_STAGEA(PG8_SA(1, 0), kstep, oAc[0]); PG8_STAGEB(PG8_SB(1, 1), cB + hstepB + kstepB);
    PG8_WAIT_V(6); PG8_BAR;
    for (;;) {
        const bool has_next = S.next(ui + 1, nxt);
        const char* nB = cB;
        if (has_next) { PG8_AOFF(oAn, nxt); nB = (const char*)g.Bt + S.boff(nxt, g.ldb) * 2; }
        else {
#pragma unroll
            for (int h = 0; h < 2; ++h)
#pragma unroll
                for (int i = 0; i < 2; ++i) oAn[h][i] = oAc[h][i];
        }
        const bool skiphi = cur.skiphi != 0;
#pragma unroll 1
        for (int t = 0; t < nt; t += 2) {
            const bool last = (t == nt - 2);
            const size_t k1 = (size_t)(t + 1) * kstep;
            const size_t k2 = last ? (size_t)0 : (size_t)(t + 2) * kstep, k3 = k2 + kstep;
            const char* b2 = last ? nB : cB + (size_t)(t + 2) * kstepB; const char* b3 = b2 + kstepB;
            unsigned o2[2][2];
#pragma unroll
            for (int h = 0; h < 2; ++h)
#pragma unroll
                for (int i = 0; i < 2; ++i) o2[h][i] = last ? oAn[h][i] : oAc[h][i];
            PG8_LDB(B0, 0, 0); PG8_LDB(B1, 0, 1); PG8_SCHED; PG8_LDA(At, 0, 0); PG8_STAGEA(PG8_SA(1, 1), k1, oAc[1]);
            PG8_WAIT_V(8); PG8_WAIT_L(0); PG8_BAR; PG8_MMA(0, 0, At, B0); PG8_MMA(0, 1, At, B1); PG8_BAR; PG8_SCHED;
            PG8_LDA(At, 0, 1); PG8_STAGEB(PG8_SB(0, 0), b2); PG8_STAGEB(PG8_SB(0, 1), b2 + hstepB); PG8_STAGEA(PG8_SA(0, 0), k2, o2[0]);
            PG8_WAIT_V(8); PG8_WAIT_L(0); PG8_BAR; if (!skiphi) { PG8_MMA(1, 0, At, B0); PG8_MMA(1, 1, At, B1); } PG8_BAR; PG8_SCHED;
            PG8_LDB(B0, 1, 0); PG8_LDB(B1, 1, 1); PG8_SCHED; PG8_LDA(At, 1, 0); PG8_STAGEA(PG8_SA(0, 1), k2, o2[1]);
            PG8_WAIT_V(8); PG8_WAIT_L(0); PG8_BAR; PG8_MMA(0, 0, At, B0); PG8_MMA(0, 1, At, B1); PG8_BAR; PG8_SCHED;
            PG8_LDA(At, 1, 1); PG8_STAGEB(PG8_SB(1, 0), b3); PG8_STAGEB(PG8_SB(1, 1), b3 + hstepB); PG8_STAGEA(PG8_SA(1, 0), k3, o2[0]);
            PG8_WAIT_V(8); PG8_WAIT_L(0); PG8_BAR; if (!skiphi) { PG8_MMA(1, 0, At, B0); PG8_MMA(1, 1, At, B1); } PG8_BAR; PG8_SCHED;
        }
        if constexpr (ALIGN_EPI) { if (wr == 0) PG8_BAR; }
        E(acc, cur, wr, wc, fr, fq);
        if (!has_next) break;
#pragma unroll
        for (int a = 0; a < 2; ++a)
#pragma unroll
            for (int b = 0; b < 2; ++b)
#pragma unroll
                for (int m = 0; m < 4; ++m)
#pragma unroll
                    for (int n = 0; n < 2; ++n) acc[a][b][m][n] = (f32x4){0.f, 0.f, 0.f, 0.f};
        cur = nxt; cB = nB; ++ui;
#pragma unroll
        for (int h = 0; h < 2; ++h)
#pragma unroll
            for (int i = 0; i < 2; ++i) oAc[h][i] = oAn[h][i];
        if constexpr (ALIGN_EPI) { if (wr == 1) PG8_BAR; }
    }
    PG8_WAIT_V(0);
    if constexpr (!ALIGN_EPI) { if (wr == 0) PG8_BAR; }
    PG8_BAR;
#undef PG8_SA
#undef PG8_SB
#undef PG8_STAGEA
#undef PG8_STAGEB
#undef PG8_LDA
#undef PG8_LDB
#undef PG8_MMA
#undef PG8_WAIT_V
#undef PG8_WAIT_L
#undef PG8_BAR
#undef PG8_SCHED
#undef PG8_AOFF
}

struct EpiBf16 {
    static constexpr bool PERM = true;
    bf16_t* O; int ldc, coloff, gcol; const float* colscale; const float* rowscale;
    __device__ __forceinline__ void operator()(const f32x4 (&acc)[2][2][4][2], const Unit& u, int wr, int wc, int fr, int fq) const {
        const int row0 = u.pm * BM + wr * 64 + fr; const int col0 = coloff + u.g * gcol + u.pn * BM + wc * 32 + 8 * fq;
        f32x4 cs[2][2];
#pragma unroll
        for (int bj = 0; bj < 2; ++bj)
#pragma unroll
            for (int n = 0; n < 2; ++n) cs[bj][n] = colscale ? *(const f32x4*)(colscale + col0 + bj * HALF + 4 * n) : (f32x4){1.f, 1.f, 1.f, 1.f};
        float rsv[2][4];
#pragma unroll
        for (int ai = 0; ai < 2; ++ai)
#pragma unroll
            for (int m = 0; m < 4; ++m) rsv[ai][m] = rowscale ? *(const GAS float*)(rowscale + row0 + ai * HALF + m * 16) : 1.f;
#pragma unroll
        for (int ai = 0; ai < 2; ++ai)
#pragma unroll
            for (int m = 0; m < 4; ++m) { const int row = row0 + ai * HALF + m * 16; bf16_t* rowp = O + (size_t)row * ldc + col0;
                const float rs = rsv[ai][m];
#pragma unroll
                for (int bj = 0; bj < 2; ++bj) { const f32x4 v0 = acc[ai][bj][m][0] * cs[bj][0] * rs, v1 = acc[ai][bj][m][1] * cs[bj][1] * rs;
                    u32x4 w; w.x = cvt_pk_bf16(v0[0], v0[1]); w.y = cvt_pk_bf16(v0[2], v0[3]); w.z = cvt_pk_bf16(v1[0], v1[1]); w.w = cvt_pk_bf16(v1[2], v1[3]);
                    *(u32x4*)(rowp + bj * HALF) = w; } }
    }
};

template <class Inner> struct EpiSig {
    static constexpr bool PERM = Inner::PERM;
    Inner in; unsigned* rdy; PG8_LAS unsigned* lcnt;
    __device__ __forceinline__ void operator()(const f32x4 (&acc)[2][2][4][2], const Unit& u, int wr, int wc, int fr, int fq) const {
        in(acc, u, wr, wc, fr, fq);
        asm volatile("s_waitcnt vmcnt(0)" ::: "memory");
        if ((fr | fq) == 0) {
            const unsigned old = __hip_atomic_fetch_add(lcnt, 1u, __ATOMIC_RELAXED, __HIP_MEMORY_SCOPE_WORKGROUP);
            if ((old & 7u) == 7u) { __builtin_amdgcn_fence(__ATOMIC_RELEASE, "agent"); asm volatile("s_waitcnt vmcnt(0)" ::: "memory");
                (void)__hip_atomic_fetch_add(rdy + u.pm, 1u, __ATOMIC_RELAXED, __HIP_MEMORY_SCOPE_AGENT); }
        }
    }
};

struct EpiG1 {
    static constexpr bool PERM = true;
    bf16_t* O; int ldc; float* GT; const float* gate_b;
    __device__ __forceinline__ void operator()(const f32x4 (&acc)[2][2][4][2], const Unit& u, int wr, int wc, int fr, int fq) const {
        const int row0 = u.pm * BM + wr * 64 + fr;
        if (u.pn < 20) {
            const int col0 = u.pn * BM + wc * 32 + 8 * fq;
#pragma unroll
            for (int ai = 0; ai < 2; ++ai)
#pragma unroll
                for (int m = 0; m < 4; ++m) { bf16_t* rowp = O + (size_t)(row0 + ai * HALF + m * 16) * ldc + col0;
#pragma unroll
                    for (int bj = 0; bj < 2; ++bj) { const f32x4 v0 = acc[ai][bj][m][0], v1 = acc[ai][bj][m][1];
                        u32x4 w; w.x = cvt_pk_bf16(v0[0], v0[1]); w.y = cvt_pk_bf16(v0[2], v0[3]); w.z = cvt_pk_bf16(v1[0], v1[1]); w.w = cvt_pk_bf16(v1[2], v1[3]);
                        *(u32x4*)(rowp + bj * HALF) = w; } }
        } else if (wc == 0 && fq < 2) {
            const f32x4 b0 = *(const f32x4*)(gate_b + 8 * fq), b1 = *(const f32x4*)(gate_b + 8 * fq + 4);
#pragma unroll
            for (int ai = 0; ai < 2; ++ai)
#pragma unroll
                for (int m = 0; m < 4; ++m) { float* gp = GT + (size_t)(row0 + ai * HALF + m * 16) * 16 + 8 * fq;
                    *(f32x4*)gp = acc[ai][0][m][0] + b0; *(f32x4*)(gp + 4) = acc[ai][0][m][1] + b1; }
        }
    }
};
struct EpiRopeQ {
    static constexpr bool PERM = true;
    bf16_t* O; int ldc; const float* tab;
    __device__ __forceinline__ void operator()(const f32x4 (&acc)[2][2][4][2], const Unit& u, int wr, int wc, int fr, int fq) const {
        const int row0 = u.pm * BM + wr * 64 + fr; const int col0 = u.pn * BM + wc * 32 + 8 * fq;
#pragma unroll
        for (int bj = 0; bj < 2; ++bj) {
            const int g32 = u.pn * 8 + bj * 4 + wc, gi = g32 % 6;
            const bool rope = gi >= 4;
#pragma unroll
            for (int ai = 0; ai < 2; ++ai)
#pragma unroll
                for (int m = 0; m < 4; ++m) { const int row = row0 + ai * HALF + m * 16; bf16_t* rowp = O + (size_t)row * ldc + col0 + bj * HALF;
                    float v[8];
#pragma unroll
                    for (int e = 0; e < 4; ++e) { v[e] = acc[ai][bj][m][0][e]; v[4 + e] = acc[ai][bj][m][1][e]; }
                    if (rope) { const float* cs = tab + (size_t)(row & 4095) * 64 + (gi - 4) * 32 + (fq & 1) * 16;
                        const bool second = fq >= 2;
#pragma unroll
                        for (int q = 0; q < 4; ++q) { const f32x4 t4 = *(const GAS f32x4*)(cs + 4 * q);
#pragma unroll
                            for (int h = 0; h < 2; ++h) { const int e = 2 * q + h; const float c = h ? t4.z : t4.x, sn = h ? t4.w : t4.y;
                                auto rr = __builtin_amdgcn_permlane32_swap(__float_as_uint(v[e]), __float_as_uint(v[e]), false, false);
                                const float pv = __uint_as_float(second ? rr[0] : rr[1]);
                                v[e] = second ? (v[e] * c + pv * sn) : (v[e] * c - pv * sn); } } }
                    u32x4 w; w.x = cvt_pk_bf16(v[0], v[1]); w.y = cvt_pk_bf16(v[2], v[3]); w.z = cvt_pk_bf16(v[4], v[5]); w.w = cvt_pk_bf16(v[6], v[7]);
                    *(u32x4*)rowp = w; }
        }
    }
};
struct EpiF32 {
    static constexpr bool PERM = true;
    float* O; int ldc;
    __device__ __forceinline__ void operator()(const f32x4 (&acc)[2][2][4][2], const Unit& u, int wr, int wc, int fr, int fq) const {
        const int row0 = u.pm * BM + wr * 64 + fr; const int col0 = u.pn * BM + wc * 32 + 8 * fq;
#pragma unroll
        for (int ai = 0; ai < 2; ++ai)
#pragma unroll
            for (int m = 0; m < 4; ++m) { float* rowp = O + (size_t)(row0 + ai * HALF + m * 16) * ldc + col0;
#pragma unroll
                for (int bj = 0; bj < 2; ++bj) { *(f32x4*)(rowp + bj * HALF) = acc[ai][bj][m][0]; *(f32x4*)(rowp + bj * HALF + 4) = acc[ai][bj][m][1]; } }
    }
};
struct EpiSwiGLU {
    static constexpr bool PERM = true;
    bf16_t* O; int ldc;
    __device__ __forceinline__ void operator()(const f32x4 (&acc)[2][2][4][2], const Unit& u, int wr, int wc, int fr, int fq) const {
        const int row0 = u.pm * BM + wr * 64 + fr; const int col0 = u.pn * HALF + wc * 32 + 8 * fq;
#pragma unroll
        for (int ai = 0; ai < 2; ++ai)
#pragma unroll
            for (int m = 0; m < 4; ++m) { bf16_t* rowp = O + (size_t)(row0 + ai * HALF + m * 16) * ldc + col0;
                float o[8];
#pragma unroll
                for (int n = 0; n < 2; ++n)
#pragma unroll
                    for (int e = 0; e < 4; ++e) { const float a = acc[ai][0][m][n][e], gg = acc[ai][1][m][n][e]; o[n * 4 + e] = a * gg * __builtin_amdgcn_rcpf(1.f + __builtin_amdgcn_exp2f(a * -1.4426950408889634f)); }
                u32x4 w; w.x = cvt_pk_bf16(o[0], o[1]); w.y = cvt_pk_bf16(o[2], o[3]); w.z = cvt_pk_bf16(o[4], o[5]); w.w = cvt_pk_bf16(o[6], o[7]);
                *(u32x4*)rowp = w; }
    }
};
}
struct Args { const float* in[26]; float* out; unsigned char* ws; int ph_lo, ph_hi; };
struct Frame {
    LAS unsigned char* lds;
    volatile LAS unsigned* MISC;
    gu32* ctl;
    unsigned char* ws;
    int tid, lane, wave, vcu, G;
    float* out;
};
#define WSP(T, off) ((T*)(F.ws + (off)))

#ifndef MOE_ORDER
#define MOE_ORDER 0
#endif
namespace pg8 {
template <bool GATHER> struct MoeOrder {
    int nMe, nN, nwg, G, c, brows; const int* ridx;
    __device__ void init(int nMe_, int nN_, int brows_, const int* ridx_, int G_, int c_) { nMe = nMe_; nN = nN_; nwg = NE * nMe * nN; brows = brows_; ridx = ridx_; G = G_; c = c_; }
    __device__ bool next(int i, Unit& u) const {
        const long L = (long)i * G + c; if (L >= nwg) return false;
        const int wgid = xcd_remap((int)L, nwg), per = nMe * nN, e = wgid / per, rem = wgid % per;
        u.g = e;
#if MOE_ORDER == 1
        u.pm = e * nMe + rem / nN; u.pn = rem % nN;
#else
        u.pm = e * nMe + rem % nMe; u.pn = rem / nMe;
#endif
        u.skiphi = (nMe == 9 && (u.pm - e * nMe) == 8) ? 1 : 0;
        return true;
    }
    __device__ __forceinline__ unsigned arow(const Unit& u, int r) const {
        if constexpr (GATHER) return (unsigned)__hip_atomic_load(ridx + u.pm * BM + r, __ATOMIC_RELAXED, __HIP_MEMORY_SCOPE_AGENT);
        else return (unsigned)(u.pm * BM + r);
    }
    __device__ __forceinline__ unsigned acol2(const Unit&) const { return 0u; }
    __device__ __forceinline__ size_t boff(const Unit& u, int ldb) const { return ((size_t)u.g * brows + (size_t)u.pn * BM) * ldb; }
};
struct PoolOrder {
    int nM, nwg, G, c;
    __device__ void init(int nM_, int G_, int c_) { nM = nM_; nwg = nM * 4; G = G_; c = c_; }
    __device__ bool next(int i, Unit& u) const { const long L = (long)i * G + c; if (L >= nwg) return false; u.pm = (int)(L >> 2); u.g = (int)(L & 3); u.pn = 0; u.skiphi = 0; return true; }
    __device__ __forceinline__ unsigned arow(const Unit& u, int r) const { return (unsigned)(u.pm * BM + r); }
    __device__ __forceinline__ unsigned acol2(const Unit& u) const { return (unsigned)u.g * 512u; }
    __device__ __forceinline__ size_t boff(const Unit& u, int ldb) const { return (size_t)u.g * 256 * ldb; }
};
struct MlaInOrder {
    int nwg, G, c;
    __device__ void init(int G_, int c_) { nwg = 64 * 9 + 4 * 3; G = G_; c = c_; }
    __device__ bool next(int i, Unit& u) const {
        const long L = (long)i * G + c; if (L >= nwg) return false; u.g = 0; u.skiphi = 0;
        if (L < 576) { const int wgid = xcd_remap((int)L, 576); const int nig = WGM * 9, gid = wgid / nig, fm = gid * WGM; u.pm = fm + (wgid % nig) % WGM; u.pn = (wgid % nig) / WGM; }
        else { const int q = (int)L - 576; u.pm = 64 + q / 3; u.pn = 6 + q % 3; }
        return true;
    }
    __device__ __forceinline__ unsigned arow(const Unit& u, int r) const { return (unsigned)(u.pm * BM + r); }
    __device__ __forceinline__ unsigned acol2(const Unit&) const { return 0u; }
    __device__ __forceinline__ size_t boff(const Unit& u, int ldb) const { return (size_t)u.pn * BM * ldb; }
};
}

__device__ __forceinline__ float rope_inv_freq(int j) { return exp2f(-(float)j * (13.287712379549449f / 16.f)); }
__device__ __forceinline__ void cv_issue(float (&v)[32], const float* W, int ldn, int k0, int sc0, int lane) {
    const float* p = W + (size_t)(k0 + (lane >> 5)) * ldn + sc0 + (lane & 31);
#pragma unroll
    for (int i = 0; i < 32; ++i) v[i] = p[(size_t)(2 * i) * ldn];
}
__device__ __forceinline__ void cv_finish(float (&v)[32], bf16* WT, int KT, int dr0, int k0, const float* kscale, int lane) {
    const int h = lane >> 5, n = lane & 31;
    if (kscale) {
#pragma unroll
        for (int i = 0; i < 32; ++i) v[i] *= kscale[k0 + 2 * i + h];
    }
    unsigned w[16];
#pragma unroll
    for (int i = 0; i < 16; ++i) { auto rr = __builtin_amdgcn_permlane32_swap(__float_as_uint(v[i]), __float_as_uint(v[i + 16]), false, false);
        unsigned r; asm volatile("v_cvt_pk_bf16_f32 %0, %1, %2" : "=v"(r) : "v"(__uint_as_float(rr[0])), "v"(__uint_as_float(rr[1]))); w[i] = r; }
    bf16* dst = WT + ((size_t)((dr0 >> 8) * KT + (k0 >> 6)) * 256 + (dr0 & 255) + n) * 64 + 32 * h;
#pragma unroll
    for (int j = 0; j < 4; ++j) *(GAS v4u*)(dst + 8 * j) = (v4u){w[4 * j], w[4 * j + 1], w[4 * j + 2], w[4 * j + 3]};
}
__device__ __forceinline__ void transpose_item(const float* W, int ldn, int k0, int sc0, bf16* WT, int KT, int dr0, const float* kscale, int lane) {
    float v[32]; cv_issue(v, W, ldn, k0, sc0, lane); cv_finish(v, WT, KT, dr0, k0, kscale, lane);
}
__device__ __forceinline__ void cvs_issue(float (&v)[16], const float* W, int ldn, int k0, int sc0, int lane) {
    const float* p = W + (size_t)(k0 + (lane >> 5)) * ldn + sc0 + (lane & 31);
#pragma unroll
    for (int i = 0; i < 16; ++i) v[i] = p[(size_t)(2 * i) * ldn];
}
__device__ __forceinline__ void cvs_finish(float (&v)[16], bf16* WT, int KT, int dr0, int k0, int lane) {
    const int h = lane >> 5, n = lane & 31;
    unsigned w[8];
#pragma unroll
    for (int i = 0; i < 8; ++i) { auto rr = __builtin_amdgcn_permlane32_swap(__float_as_uint(v[i]), __float_as_uint(v[i + 8]), false, false);
        unsigned r; asm volatile("v_cvt_pk_bf16_f32 %0, %1, %2" : "=v"(r) : "v"(__uint_as_float(rr[0])), "v"(__uint_as_float(rr[1]))); w[i] = r; }
    bf16* dst = WT + ((size_t)((dr0 >> 8) * KT + (k0 >> 6)) * 256 + (dr0 & 255) + n) * 64 + (k0 & 63) + 16 * h;
    *(GAS v4u*)dst = (v4u){w[0], w[1], w[2], w[3]}; *(GAS v4u*)(dst + 8) = (v4u){w[4], w[5], w[6], w[7]};
}
constexpr int MOE_ITEMS = 3 * 32 * 2048 + 2 * 2048;
constexpr int MOE_L1_ITEMS = 3 * 16 * 2048, MOE_SCAN_STEPS = 50, MOE_SCAN_ITEMS = MOE_SCAN_STEPS * 256 * 8, CVA_PER_UNIT = 24;
static_assert(MOE_SCAN_ITEMS + MOE_L1_ITEMS == MOE_ITEMS && 4 * CVA_PER_UNIT * 2048 == 2 * MOE_L1_ITEMS, "every item is converted exactly once");
__device__ __forceinline__ int moe_scan_m(int s) { return s < 3 * 32768 ? (s >> 15) * 65536 + (s & 32767) : 3 * 65536 + (s - 3 * 32768); }
__device__ __forceinline__ int moe_l1_m(int q) { return (q >> 15) * 65536 + 32768 + (q & 32767); }
struct MoeItem { const float* src; bf16* dst; int k0, n0, dr0; };
__device__ __forceinline__ MoeItem moe_item(Frame& F, const Args& A, int m) {
    const int which = m >> 16, q = m & 65535, le = q >> 11, q2 = q & 2047, kb = q2 >> 6, nb = q2 & 63, n0 = 32 * nb;
    MoeItem it; it.k0 = 64 * kb; it.n0 = n0;
    const float* s1 = A.in[23]; const float* s3 = A.in[24]; const float* s2 = A.in[25];
    it.src = (which == 0 ? s1 : which == 1 ? s3 : s2) + (size_t)le * 2048 * 2048;
    it.dst = (which == 2) ? WSP(bf16, WS_WM2) + (size_t)le * 2048 * 2048 : WSP(bf16, WS_WM13) + (size_t)le * 4096 * 2048;
    it.dr0 = (which >= 2) ? n0 : (n0 >> 7) * 256 + (n0 & 127) + which * 128;
    if (which == 3) { it.src = le == 0 ? A.in[15] : A.in[21]; it.dst = le == 0 ? WSP(bf16, WS_WOUT0) : WSP(bf16, WS_WO); }
    return it;
}
__device__ __forceinline__ void p0_prologue(Frame& F, const Args& A) {
    LAS float* scond = (LAS float*)(F.lds + 73728);
    LAS float* red = (LAS float*)(F.lds + 73728 + 40960);
    for (int i = F.tid; i < 5 * 2048; i += 512) { const int r = i >> 11, k = i & 2047; const float v = (r < 4) ? A.in[1][r * 2048 + k] : A.in[3][k]; scond[i] = siluf(v); }
    __syncthreads();
    float* MOD = WSP(float, WS_MOD);
    for (int j = 0; j < 2; ++j) {
        const int tk = F.vcu + 256 * j;
        if (tk < 384) {
            const int l = tk / 192, col0 = (tk % 192) * 64;
            const float* W = A.in[4] + (size_t)l * 2048 * 12288 + col0 + F.lane;
            float a0 = 0.f, a1 = 0.f, a2 = 0.f, a3 = 0.f, a4 = 0.f;
            const int kb = F.wave * 256;
#pragma unroll 8
            for (int k = 0; k < 256; ++k) { const float w = W[(size_t)(kb + k) * 12288];
                a0 += scond[0 * 2048 + kb + k] * w; a1 += scond[1 * 2048 + kb + k] * w; a2 += scond[2 * 2048 + kb + k] * w; a3 += scond[3 * 2048 + kb + k] * w; a4 += scond[4 * 2048 + kb + k] * w; }
            red[(F.wave * 5 + 0) * 64 + F.lane] = a0; red[(F.wave * 5 + 1) * 64 + F.lane] = a1; red[(F.wave * 5 + 2) * 64 + F.lane] = a2; red[(F.wave * 5 + 3) * 64 + F.lane] = a3; red[(F.wave * 5 + 4) * 64 + F.lane] = a4;
        }
        __syncthreads();
        if (tk < 384 && F.tid < 320) {
            const int l = tk / 192, col0 = (tk % 192) * 64, r = F.tid >> 6, cc = F.tid & 63;
            float s = A.in[5][l * 12288 + col0 + cc];
#pragma unroll
            for (int w = 0; w < 8; ++w) s += red[(w * 5 + r) * 64 + cc];
            MOD[(size_t)(l * 5 + r) * 12288 + col0 + cc] = s;
        }
        __syncthreads();
    }
    for (int gid = F.vcu * 512 + F.tid; gid < 4096 * 32; gid += F.G * 512) {
        const int t = gid >> 5, a = (gid >> 4) & 1, j = gid & 15; float sn, cs; sincosf((float)(a ? (t & 63) : (t >> 6)) * rope_inv_freq(j), &sn, &cs);
        *(f32x2*)(WSP(float, WS_ROPE) + (size_t)gid * 2) = (f32x2){cs, sn}; }
    const int gw = F.vcu * NWAVES + F.wave, NGW = F.G * NWAVES;
    constexpr int I_IN0 = 32 * 160, I_OUT0 = 32 * 64, I_POOL = 4 * 4 * 8, I_MIN = 32 * 66, I_MINZ = 6 * 32, I_UQ = 24 * 96, I_UKV = 8 * 128, I_O = 32 * 64, I_E = 32 * 64;
    constexpr int I_SMALL = I_IN0 + I_POOL + I_MIN + I_MINZ + I_UQ + I_UKV;
    constexpr int I_GATE = 32; constexpr int NITEMS = I_SMALL + I_GATE;
    for (int it = gw; it < NITEMS; it += NGW) {
        int r = it;
        if (r < I_IN0) { const int kb = r / 160, nb = r % 160, dr = 32 * nb; transpose_item(A.in[8], INAB, 64 * kb, dr < 4096 ? dr : dr + 16, WSP(bf16, WS_WIN0), 32, dr, nullptr, F.lane); continue; } r -= I_IN0;
        if (r < I_POOL) { const int gq = r / 32, q = r % 32, kb = q / 8, nb = q % 8; transpose_item(A.in[13] + gq * 65536, 256, 64 * kb, 32 * nb, WSP(bf16, WS_WPOOL) + gq * 65536, 4, 32 * nb, nullptr, F.lane); continue; } r -= I_POOL;
        if (r < I_MIN) { const int kb = r / 66, nb = r % 66; transpose_item(A.in[16], INC, 64 * kb, 32 * nb, WSP(bf16, WS_WMIN), 32, 32 * nb, nullptr, F.lane); continue; } r -= I_MIN;
        if (r < I_MINZ) { const int rb = r / 32, kb = r % 32; bf16* Z = WSP(bf16, WS_WMIN) + ((size_t)(8 * 32 + kb) * 256 + 64 + 32 * rb) * 64;
#pragma unroll
            for (int j = 0; j < 4; ++j) { const int n = (F.lane >> 3) + 8 * j; *(GAS v4u*)(Z + n * 64 + 8 * (F.lane & 7)) = (v4u){0u, 0u, 0u, 0u}; }
            continue; } r -= I_MINZ;
        if (r < I_UQ) { const int kb = r / 96, nb = r % 96; transpose_item(A.in[19], 3072, 64 * kb, 32 * nb, WSP(bf16, WS_WUQ), 24, 32 * nb, A.in[17], F.lane); continue; } r -= I_UQ;
        if (r < I_UKV) { const int kb = r / 128, nb = r % 128; transpose_item(A.in[20], 4096, 64 * kb, 32 * nb, WSP(bf16, WS_WUKV), 8, 32 * nb, A.in[18], F.lane); continue; } r -= I_UKV;
        transpose_item(A.in[8], INAB, 64 * r, 4096, WSP(bf16, WS_WIN0), 32, 5120, nullptr, F.lane);
    }
}

__device__ __forceinline__ const float* mod_ptr(Frame& F, const Args& A, int layer, int brow, int k) { return WSP(float, WS_MOD) + (size_t)(layer * 5 + brow) * 12288 + k * 2048; }
__device__ __forceinline__ int brow_of(int r) { return r < NL ? (r >> 12) : 4; }
__device__ __forceinline__ void store_bf16_row(bf16* orow, const f32x4 (&v)[8], int lane) {
    GAS unsigned long long* o8 = (GAS unsigned long long*)orow + lane;
#pragma unroll
    for (int j = 0; j < 8; ++j) o8[64 * j] = (unsigned long long)pk2(v[j].x, v[j].y) | ((unsigned long long)pk2(v[j].z, v[j].w) << 32);
}
typedef float f32x2 __attribute__((ext_vector_type(2)));
__device__ __forceinline__ int rd16_col(int lane) { return 4 * (lane & 3) + (lane >> 4); }
__device__ __forceinline__ float row_dot16(const f32x4 (&v)[8], const LAS float* wT, int lane) {
    float mine = 0.f;
#pragma unroll 1
    for (int g = 0; g < 4; ++g) { float s[4];
#pragma unroll
        for (int c = 0; c < 4; ++c) { f32x2 a0 = (f32x2){0.f, 0.f}, a1 = (f32x2){0.f, 0.f};
#pragma unroll
            for (int j = 0; j < 8; ++j) { const f32x4 w = *(const LAS f32x4*)(wT + (g * 4 + c) * 2048 + j * 256 + lane * 4);
                a0 = __builtin_elementwise_fma((f32x2){v[j].x, v[j].y}, (f32x2){w.x, w.y}, a0); a1 = __builtin_elementwise_fma((f32x2){v[j].z, v[j].w}, (f32x2){w.z, w.w}, a1); }
            a0 += a1; s[c] = a0.x + a0.y;
            if (c == 1) asm volatile("" ::: "memory");
        }
        float p, q, r;
        { auto rr = __builtin_amdgcn_permlane32_swap(__float_as_uint(s[0]), __float_as_uint(s[2]), false, false); p = __uint_as_float(rr[0]) + __uint_as_float(rr[1]); }
        { auto rr = __builtin_amdgcn_permlane32_swap(__float_as_uint(s[1]), __float_as_uint(s[3]), false, false); q = __uint_as_float(rr[0]) + __uint_as_float(rr[1]); }
        { auto rr = __builtin_amdgcn_permlane16_swap(__float_as_uint(p), __float_as_uint(q), false, false); r = __uint_as_float(rr[0]) + __uint_as_float(rr[1]); }
        r += dpp_mov<0xB1>(r); r += dpp_mov<0x4E>(r); r += dpp_mov<0x141>(r); r += dpp_mov<0x140>(r);
        mine = ((lane & 3) == g) ? r : mine; }
    return mine;
}
__device__ __forceinline__ float rd16_max(float x) {
    x = fmaxf(x, dpp_mov<0xB1>(x)); x = fmaxf(x, dpp_mov<0x4E>(x));
    { auto rr = __builtin_amdgcn_permlane16_swap(__float_as_uint(x), __float_as_uint(x), false, false); x = fmaxf(__uint_as_float(rr[0]), __uint_as_float(rr[1])); }
    { auto rr = __builtin_amdgcn_permlane32_swap(__float_as_uint(x), __float_as_uint(x), false, false); x = fmaxf(__uint_as_float(rr[0]), __uint_as_float(rr[1])); }
    return x;
}
__device__ __forceinline__ float rd16_sum(float x) {
    x += dpp_mov<0xB1>(x); x += dpp_mov<0x4E>(x);
    { auto rr = __builtin_amdgcn_permlane16_swap(__float_as_uint(x), __float_as_uint(x), false, false); x = __uint_as_float(rr[0]) + __uint_as_float(rr[1]); }
    { auto rr = __builtin_amdgcn_permlane32_swap(__float_as_uint(x), __float_as_uint(x), false, false); x = __uint_as_float(rr[0]) + __uint_as_float(rr[1]); }
    return x;
}
__device__ __forceinline__ void load_wT16(Frame& F, const Args& A, const float* src, int ld, LAS float* wT) {
    f32x4 w[4][4];
#pragma unroll
    for (int m = 0; m < 4; ++m) { const float* p = src + (size_t)(F.tid + 512 * m) * ld;
#pragma unroll
        for (int q = 0; q < 4; ++q) w[m][q] = *(const f32x4*)(p + 4 * q); }
#pragma unroll
    for (int m = 0; m < 4; ++m) { const int k = F.tid + 512 * m;
#pragma unroll
        for (int q = 0; q < 4; ++q) { wT[(4 * q + 0) * 2048 + k] = w[m][q].x; wT[(4 * q + 1) * 2048 + k] = w[m][q].y; wT[(4 * q + 2) * 2048 + k] = w[m][q].z; wT[(4 * q + 3) * 2048 + k] = w[m][q].w; } }
    __syncthreads();
}
__device__ __forceinline__ void ln_affine(f32x4 (&v)[8], const float* g, const float* b, int lane) {
    float s = 0.f;
#pragma unroll
    for (int j = 0; j < 8; ++j) s += (v[j].x + v[j].y) + (v[j].z + v[j].w);
    const float mean = wave_sum(s) * (1.f / 2048.f); float s2 = 0.f;
#pragma unroll
    for (int j = 0; j < 8; ++j) { v[j] = v[j] - mean; s2 += (v[j].x * v[j].x + v[j].y * v[j].y) + (v[j].z * v[j].z + v[j].w * v[j].w); }
    const float rstd = 1.f / sqrtf(wave_sum(s2) * (1.f / 2048.f) + LN_EPS);
#pragma unroll
    for (int j = 0; j < 8; ++j) { const f32x4 gg = *(const f32x4*)(g + j * 256 + lane * 4), bb = *(const f32x4*)(b + j * 256 + lane * 4); v[j] = v[j] * rstd * gg + bb; }
}

__device__ __forceinline__ void stage_gb(Frame& F, LAS float* gb, const float* g, const float* b) {
    *(LAS f32x4*)(gb + F.tid * 4) = *(const f32x4*)(g + F.tid * 4); *(LAS f32x4*)(gb + 2048 + F.tid * 4) = *(const f32x4*)(b + F.tid * 4);
}
__device__ __forceinline__ void ln_affine_lds(f32x4 (&v)[8], const LAS float* gb, int lane) {
    float s = 0.f;
#pragma unroll
    for (int j = 0; j < 8; ++j) s += (v[j].x + v[j].y) + (v[j].z + v[j].w);
    const float mean = wave_sum(s) * (1.f / 2048.f); float s2 = 0.f;
#pragma unroll
    for (int j = 0; j < 8; ++j) { v[j] = v[j] - mean; s2 += (v[j].x * v[j].x + v[j].y * v[j].y) + (v[j].z * v[j].z + v[j].w * v[j].w); }
    const float rstd = 1.f / sqrtf(wave_sum(s2) * (1.f / 2048.f) + LN_EPS);
#pragma unroll
    for (int j = 0; j < 8; ++j) { const f32x4 gg = *(const LAS f32x4*)(gb + j * 256 + lane * 4), bb = *(const LAS f32x4*)(gb + 2048 + j * 256 + lane * 4); v[j] = v[j] * rstd * gg + bb; }
}

__device__ __forceinline__ void ph_mod0(Frame& F, const Args& A) {
    const int gw = F.vcu * NWAVES + F.wave, NGW = F.G * NWAVES;
    bf16* H = WSP(bf16, WS_H);
    f32x4 xn[8];
#define M0_LOAD(rr) do { const int r_ = (rr); const float* xr_ = (r_ < NL) ? A.in[0] + (size_t)r_ * DM : A.in[2] + (size_t)(r_ - NL) * DM; \
        _Pragma("unroll") for (int j = 0; j < 8; ++j) xn[j] = *(const f32x4*)(xr_ + j * 256 + F.lane * 4); } while (0)
    if (gw < R0) M0_LOAD(gw);
    for (int r = gw; r < R0; r += NGW) {
        const int br = brow_of(r); const float* sh = mod_ptr(F, A, 0, br, 0); const float* sc = mod_ptr(F, A, 0, br, 1);
        f32x4 s1[8], s0[8], x[8];
#pragma unroll
        for (int j = 0; j < 8; ++j) { const int col = j * 256 + F.lane * 4; s1[j] = *(const GAS f32x4*)(sc + col); s0[j] = *(const GAS f32x4*)(sh + col); x[j] = xn[j]; }
        asm volatile("" : "+v"(x[0]), "+v"(x[1]), "+v"(x[2]), "+v"(x[3]), "+v"(x[4]), "+v"(x[5]), "+v"(x[6]), "+v"(x[7]) :: "memory");
        { const int rn = (r + NGW < R0) ? r + NGW : r; M0_LOAD(rn); }
        asm volatile("" ::: "memory");
        f32x4 v[8];
#pragma unroll
        for (int j = 0; j < 8; ++j) v[j] = x[j] * (1.f + s1[j]) + s0[j];
        store_bf16_row(H + (size_t)r * DM, v, F.lane);
    }
#undef M0_LOAD
}

__device__ __forceinline__ void unpk8(const v4u z, float (&o)[8]) {
#pragma unroll
    for (int e = 0; e < 4; ++e) { o[2 * e] = bflo(z[e]); o[2 * e + 1] = bfhi(z[e]); }
}
template <int HWMAX>
__device__ __forceinline__ void pool_item(const bf16* PB, bf16* PU, int r0, int t0, int T, int col, int lane) {
    const int gq = col >> 8, hw = 1 << gq;
    constexpr int NR = 2 * HWMAX + 3;
    const bf16* ub = PB + (size_t)r0 * PW + 4096 + col;
    v4u z[NR];
#pragma unroll
    for (int i = 0; i < NR; ++i) { const int t = t0 - HWMAX + i; z[i] = (t >= 0 && t < T) ? *(const GAS v4u*)(ub + (ptrdiff_t)(i - HWMAX) * PW) : (v4u){0u, 0u, 0u, 0u}; }
    float sa[8], sb[8];
#pragma unroll
    for (int e = 0; e < 8; ++e) { sa[e] = 0.f; sb[e] = 0.f; }
#pragma unroll
    for (int q = -HWMAX; q < HWMAX; ++q) { float u[8]; unpk8(z[q + HWMAX], u);
#pragma unroll
        for (int e = 0; e < 8; ++e) { sb[e] += u[e]; if (q >= -HWMAX / 2 && q < HWMAX / 2) sa[e] += u[e]; } }
    const bool big = (hw == HWMAX);
#pragma unroll
    for (int i = 0; i < 4; ++i) {
        const int t = t0 + i; int lo = t - hw, hi = t + hw; lo = lo < 0 ? 0 : lo; hi = hi > T ? T : hi;
        const float inv = 1.f / (float)(hi - lo);
        float c[8]; unpk8(z[i + HWMAX], c); float o[8];
#pragma unroll
        for (int e = 0; e < 8; ++e) o[e] = (big ? sb[e] : sa[e]) * inv - c[e];
        v4u w; w.x = pk2(o[0], o[1]); w.y = pk2(o[2], o[3]); w.z = pk2(o[4], o[5]); w.w = pk2(o[6], o[7]);
        *(GAS v4u*)(PU + (size_t)(r0 + i) * 1024 + col) = w;
        if (i < 3) {
            float p1[8], m1[8], p2[8], m2[8]; unpk8(z[i + HWMAX + HWMAX], p2); unpk8(z[i], m2); unpk8(z[i + HWMAX + HWMAX / 2], p1); unpk8(z[i + HWMAX - HWMAX / 2], m1);
#pragma unroll
            for (int e = 0; e < 8; ++e) { sb[e] += p2[e] - m2[e]; sa[e] += p1[e] - m1[e]; }
        }
    }
}
__device__ __forceinline__ void ph_conv_pool(Frame& F, const Args& A) {
    const int gw = F.vcu * NWAVES + F.wave, NGW = F.G * NWAVES;
    const bf16* PB = WSP(bf16, WS_PB); bf16* QK = WSP(bf16, WS_QK); bf16* PU = WSP(bf16, WS_PU);
    constexpr int NSTRIP = R0 / 4;
    for (int it = gw; it < NSTRIP * 6; it += NGW) {
        const int jj = it / NSTRIP, strip = it % NSTRIP, r0 = strip * 4;
        int t0, T; if (r0 < NL) { t0 = r0 & 4095; T = SEQ; } else { t0 = (r0 - NL) & 255; T = CTXL; }
        if (jj < 4) {
            const int col = jj * 512 + F.lane * 8;
            float wm[8], wc[8], wp[8], bb[8];
#pragma unroll
            for (int h = 0; h < 2; ++h) { const f32x4 a = *(const f32x4*)(A.in[9] + col + 4 * h), b = *(const f32x4*)(A.in[9] + 2048 + col + 4 * h), c = *(const f32x4*)(A.in[9] + 4096 + col + 4 * h), d = *(const f32x4*)(A.in[10] + col + 4 * h);
#pragma unroll
                for (int e = 0; e < 4; ++e) { wm[4 * h + e] = a[e]; wc[4 * h + e] = b[e]; wp[4 * h + e] = c[e]; bb[4 * h + e] = d[e]; } }
            const bf16* p0 = PB + (size_t)r0 * PW + col;
            v4u z[6];
#pragma unroll
            for (int i = 0; i < 6; ++i) { const int t = t0 - 1 + i; z[i] = (t >= 0 && t < T) ? *(const GAS v4u*)(p0 + (ptrdiff_t)(i - 1) * PW) : (v4u){0u, 0u, 0u, 0u}; }
            const float ksc = (col >= 1024) ? 0.0625f : 1.f;
#pragma unroll
            for (int i = 0; i < 4; ++i) { float pm[8], pc[8], pp[8], o[8]; unpk8(z[i], pm); unpk8(z[i + 1], pc); unpk8(z[i + 2], pp);
#pragma unroll
                for (int e = 0; e < 8; ++e) { const float a = wm[e] * pm[e] + wc[e] * pc[e] + wp[e] * pp[e] + bb[e]; o[e] = siluf(a) * ksc; }
                v4u w; w.x = pk2(o[0], o[1]); w.y = pk2(o[2], o[3]); w.z = pk2(o[4], o[5]); w.w = pk2(o[6], o[7]);
                *(GAS v4u*)(QK + (size_t)(r0 + i) * 2048 + col) = w; }
        } else if (jj == 4) pool_item<2>(PB, PU, r0, t0, T, F.lane * 8, F.lane);
        else pool_item<8>(PB, PU, r0, t0, T, 512 + F.lane * 8, F.lane);
    }
}

__device__ __forceinline__ void ph_readout(Frame& F, const Args& A) {
    const int gw = F.vcu * NWAVES + F.wave, NGW = F.G * NWAVES;
    const bf16* HF = WSP(bf16, WS_HF); const bf16* HB = HF + (size_t)R0 * 1024; const bf16* PB = WSP(bf16, WS_PB); bf16* A2 = WSP(bf16, WS_A2);
    f32x4 hg[4];
#pragma unroll
    for (int jj = 0; jj < 4; ++jj) hg[jj] = *(const f32x4*)(A.in[12] + jj * 256 + F.lane * 4);
    v2u hfn[4], hbn[4], own[4];
#define RO_LOAD(rr) do { const int r_ = (rr); _Pragma("unroll") for (int jj = 0; jj < 4; ++jj) { const int col = jj * 256 + F.lane * 4; \
        hfn[jj] = *(const GAS v2u*)(HF + (size_t)r_ * 1024 + col); hbn[jj] = *(const GAS v2u*)(HB + (size_t)r_ * 1024 + col); own[jj] = *(const GAS v2u*)(PB + (size_t)r_ * PW + 3072 + col); } } while (0)
    if (gw < R0) RO_LOAD(gw);
    for (int r = gw; r < R0; r += NGW) {
        v2u hf[4], hb[4], ow[4];
#pragma unroll
        for (int jj = 0; jj < 4; ++jj) { hf[jj] = hfn[jj]; hb[jj] = hbn[jj]; ow[jj] = own[jj]; }
        asm volatile("" : "+v"(hf[0]), "+v"(hf[1]), "+v"(hf[2]), "+v"(hf[3]), "+v"(hb[0]), "+v"(hb[1]), "+v"(hb[2]), "+v"(hb[3]), "+v"(ow[0]), "+v"(ow[1]), "+v"(ow[2]), "+v"(ow[3]) :: "memory");
        { const int rn = (r + NGW < R0) ? r + NGW : r; RO_LOAD(rn); }
        asm volatile("" ::: "memory");
#pragma unroll
        for (int jj = 0; jj < 4; ++jj) {
            const int col = jj * 256 + F.lane * 4;
            f32x4 v = (f32x4){bflo(hf[jj].x) + bflo(hb[jj].x), bfhi(hf[jj].x) + bfhi(hb[jj].x), bflo(hf[jj].y) + bflo(hb[jj].y), bfhi(hf[jj].y) + bfhi(hb[jj].y)};
            const float mean = wave_sum((v.x + v.y) + (v.z + v.w)) * (1.f / 256.f);
            v = v - mean;
            const float rstd = 1.f / sqrtf(wave_sum((v.x * v.x + v.y * v.y) + (v.z * v.z + v.w * v.w)) * (1.f / 256.f) + LN_EPS);
            f32x4 o; o.x = v.x * rstd * hg[jj].x * sigmoidf_(bflo(ow[jj].x)); o.y = v.y * rstd * hg[jj].y * sigmoidf_(bfhi(ow[jj].x)); o.z = v.z * rstd * hg[jj].z * sigmoidf_(bflo(ow[jj].y)); o.w = v.w * rstd * hg[jj].w * sigmoidf_(bfhi(ow[jj].y));
            *(GAS unsigned long long*)(A2 + (size_t)r * 2048 + col) = (unsigned long long)pk2(o.x, o.y) | ((unsigned long long)pk2(o.z, o.w) << 32);
        }
    }
#undef RO_LOAD
}

__device__ __forceinline__ void ph_post1(Frame& F, const Args& A, int layer, int first, int step, int rend, unsigned* rdy, unsigned need, int blk_lo, int blk_hi) {
    LAS float* wT = (LAS float*)F.lds; LAS float* gb = (LAS float*)(F.lds + 131072);
    stage_gb(F, gb, A.in[6] + (size_t)(layer * 2 + 0) * 2048, A.in[7] + (size_t)(layer * 2 + 0) * 2048);
    load_wT16(F, A, A.in[22] + (size_t)layer * 2048 * 16, 16, wT);
    bf16* X1 = WSP(bf16, WS_X1); const bf16* Y = WSP(bf16, WS_Y); bf16* H = WSP(bf16, WS_H); float* AFF = WSP(float, WS_AFF);
    f32x4 xn[8]; v2u yn[8];
#define P1_LOAD(rr) do { const int r_ = (rr); const float* xr_ = (r_ < NL) ? A.in[0] + (size_t)r_ * DM : A.in[2] + (size_t)(r_ - NL) * DM; \
        _Pragma("unroll") for (int j = 0; j < 8; ++j) { const int col = j * 256 + F.lane * 4; \
            if (layer == 0) xn[j] = *(const GAS f32x4*)(xr_ + col); else { const v2u xw_ = *(const GAS v2u*)(X1 + (size_t)r_ * DM + col); xn[j] = (f32x4){bflo(xw_.x), bfhi(xw_.x), bflo(xw_.y), bfhi(xw_.y)}; } \
            yn[j] = *(const GAS v2u*)(Y + (size_t)r_ * DM + col); } } while (0)
    if (rdy) {
        if (F.wave == 0) { unsigned* bar = (unsigned*)(F.ctl + CW_BAR);
            for (int b0 = blk_lo; b0 <= blk_hi; b0 += 64) { const int blk = b0 + F.lane; XB_SPIN(!__all(blk > blk_hi || xb_ld(rdy + blk) >= need), bar); }
            __builtin_amdgcn_fence(__ATOMIC_ACQUIRE, "agent"); asm volatile("s_waitcnt vmcnt(0)" ::: "memory"); }
        __syncthreads();
    }
    if (first < rend) P1_LOAD(first);
    for (int r = first; r < rend; r += step) {
        const int br = brow_of(r); const float* ga = mod_ptr(F, A, layer, br, 2); const float* shf = mod_ptr(F, A, layer, br, 3); const float* scf = mod_ptr(F, A, layer, br, 4);
        f32x4 g1[8], s1[8], s0[8];
#pragma unroll
        for (int j = 0; j < 8; ++j) { const int col = j * 256 + F.lane * 4; g1[j] = *(const GAS f32x4*)(ga + col); }
        f32x4 v[8];
#pragma unroll
        for (int j = 0; j < 8; ++j) { const f32x4 yv = (f32x4){bflo(yn[j].x), bfhi(yn[j].x), bflo(yn[j].y), bfhi(yn[j].y)}; v[j] = xn[j] * ALPHA + (1.f + g1[j]) * yv; }
        asm volatile("" : "+v"(v[0]), "+v"(v[1]), "+v"(v[2]), "+v"(v[3]), "+v"(v[4]), "+v"(v[5]), "+v"(v[6]), "+v"(v[7]) :: "memory");
#pragma unroll
        for (int j = 0; j < 8; ++j) { const int col = j * 256 + F.lane * 4; s1[j] = *(const GAS f32x4*)(scf + col); s0[j] = *(const GAS f32x4*)(shf + col); }
        asm volatile("" ::: "memory");
        { const int rn = (r + step < rend) ? r + step : r; P1_LOAD(rn); }
        asm volatile("" ::: "memory");
        ln_affine_lds(v, gb, F.lane);
        store_bf16_row(X1 + (size_t)r * DM, v, F.lane);
#pragma unroll
        for (int j = 0; j < 8; ++j) v[j] = v[j] * (1.f + s1[j]) + s0[j];
        store_bf16_row(H + (size_t)r * DM, v, F.lane);
        const float lgt = row_dot16(v, wT, F.lane);
        const float mx = rd16_max(lgt); const float o = expf(lgt - mx); const float sum = rd16_sum(o);
        if ((F.lane & 12) == 0) AFF[(size_t)r * 16 + rd16_col(F.lane)] = o / sum;
    }
#undef P1_LOAD
}

__device__ __forceinline__ void ph_combine(Frame& F, const Args& A, int layer, int nrows, int slots) {
    const int gw = F.vcu * NWAVES + F.wave, NGW = F.G * NWAVES;
    bf16* X1 = WSP(bf16, WS_X1); bf16* H = WSP(bf16, WS_H); const bf16* YS = WSP(bf16, WS_YS); const int* RSLOT = WSP(int, WS_RSLOT);
    LAS float* gb = (LAS float*)F.lds;
    __syncthreads(); stage_gb(F, gb, A.in[6] + (size_t)(layer * 2 + 1) * 2048, A.in[7] + (size_t)(layer * 2 + 1) * 2048); __syncthreads();
    const float* AFF = WSP(float, WS_AFF);
    f32x4 xn[8]; int slot_n = -1; float aff_n = 0.f;
#define CB_LOAD(rr) do { const int r_ = (rr); slot_n = (F.lane < 16) ? __hip_atomic_load(RSLOT + (size_t)r_ * 16 + F.lane, __ATOMIC_RELAXED, __HIP_MEMORY_SCOPE_AGENT) : -1; \
        aff_n = *(const GAS float*)(AFF + (size_t)r_ * 16 + (F.lane & 15)); \
        _Pragma("unroll") for (int j = 0; j < 8; ++j) { const v2u xw_ = *(const GAS v2u*)(X1 + (size_t)r_ * DM + j * 256 + F.lane * 4); xn[j] = (f32x4){bflo(xw_.x), bfhi(xw_.x), bflo(xw_.y), bfhi(xw_.y)}; } } while (0)
    if (gw < nrows) CB_LOAD(gw);
    for (int r = gw; r < nrows; r += NGW) {
        const int br = brow_of(r); const float* gaf = mod_ptr(F, A, layer, br, 5);
        f32x4 f[8];
#pragma unroll
        for (int j = 0; j < 8; ++j) f[j] = (f32x4){0.f, 0.f, 0.f, 0.f};
        const int myslot = slot_n; const int myaff = __float_as_int(aff_n);
        unsigned mask = (unsigned)__ballot(myslot >= 0) & 0xffffu;
        while (mask) {
            const int e1 = __builtin_ctz(mask); mask &= mask - 1u;
            const bool two = mask != 0u; const int e2 = two ? __builtin_ctz(mask) : e1; if (two) mask &= mask - 1u;
            const int s1 = __builtin_amdgcn_readlane(myslot, e1), s2 = __builtin_amdgcn_readlane(myslot, e2);
            const bf16* y1 = YS + ((size_t)e1 * slots + s1) * 2048; const bf16* y2 = YS + ((size_t)e2 * slots + s2) * 2048;
            v2u w1[8], w2[8];
#pragma unroll
            for (int j = 0; j < 8; ++j) { w1[j] = *(const GAS v2u*)(y1 + j * 256 + F.lane * 4); w2[j] = *(const GAS v2u*)(y2 + j * 256 + F.lane * 4); }
            const float k1 = __int_as_float(__builtin_amdgcn_readlane(myaff, e1)), k2 = two ? __int_as_float(__builtin_amdgcn_readlane(myaff, e2)) : 0.f;
#pragma unroll
            for (int j = 0; j < 8; ++j) { f[j].x += k1 * bflo(w1[j].x) + k2 * bflo(w2[j].x); f[j].y += k1 * bfhi(w1[j].x) + k2 * bfhi(w2[j].x); f[j].z += k1 * bflo(w1[j].y) + k2 * bflo(w2[j].y); f[j].w += k1 * bfhi(w1[j].y) + k2 * bfhi(w2[j].y); }
        }
        f32x4 v[8];
#pragma unroll
        for (int j = 0; j < 8; ++j) { const int col = j * 256 + F.lane * 4; const f32x4 g1 = *(const GAS f32x4*)(gaf + col); v[j] = xn[j] * ALPHA + (1.f + g1) * f[j]; }
        asm volatile("" : "+v"(v[0]), "+v"(v[1]), "+v"(v[2]), "+v"(v[3]), "+v"(v[4]), "+v"(v[5]), "+v"(v[6]), "+v"(v[7]) :: "memory");
        f32x4 s1v[8], s0v[8];
        if (layer == 0) { const float* sh = mod_ptr(F, A, 1, br, 0); const float* sc = mod_ptr(F, A, 1, br, 1);
#pragma unroll
            for (int j = 0; j < 8; ++j) { const int col = j * 256 + F.lane * 4; s1v[j] = *(const GAS f32x4*)(sc + col); s0v[j] = *(const GAS f32x4*)(sh + col); } }
        asm volatile("" ::: "memory");
        { const int rn = (r + NGW < nrows) ? r + NGW : r; CB_LOAD(rn); }
        asm volatile("" ::: "memory");
        ln_affine_lds(v, gb, F.lane);
        if (layer == 0) {
            store_bf16_row(X1 + (size_t)r * DM, v, F.lane);
#pragma unroll
            for (int j = 0; j < 8; ++j) v[j] = v[j] * (1.f + s1v[j]) + s0v[j];
            store_bf16_row(H + (size_t)r * DM, v, F.lane);
        } else {
#pragma unroll
            for (int j = 0; j < 8; ++j) *(f32x4*)(F.out + (size_t)r * DM + j * 256 + F.lane * 4) = v[j];
        }
    }
}

#undef CB_LOAD
__device__ __forceinline__ void ph_mla_norm(Frame& F, const Args& A) {
    const int gw = F.vcu * NWAVES + F.wave, NGW = F.G * NWAVES;
    const bf16* PL = WSP(bf16, WS_PL); bf16* QN = WSP(bf16, WS_QN); bf16* KVN = WSP(bf16, WS_KVN); bf16* KPE = WSP(bf16, WS_KPE);
    const int l = F.lane & 7;
    v4u zqn[3], zkn, zrn; f32x4 tbn[4];
#define MN_LOAD(rr) do { const int r_ = (rr); const bf16* pr_ = PL + (size_t)r_ * PLW; const int t_ = (r_ < NL) ? (r_ & 4095) : ((r_ - NL) & 255); \
        _Pragma("unroll") for (int jj = 0; jj < 3; ++jj) zqn[jj] = *(const GAS v4u*)(pr_ + jj * 512 + F.lane * 8); \
        zkn = *(const GAS v4u*)(pr_ + 1536 + F.lane * 8); zrn = *(const GAS v4u*)(pr_ + 2048 + l * 8); \
        const float* cst_ = WSP(float, WS_ROPE) + (size_t)t_ * 64 + (l >> 2) * 32 + (l & 1) * 16; \
        _Pragma("unroll") for (int q = 0; q < 4; ++q) tbn[q] = *(const GAS f32x4*)(cst_ + 4 * q); } while (0)
    if (gw < R0) MN_LOAD(gw);
    for (int r = gw; r < R0; r += NGW) {
        int b, t, kvrow; const bool lat = r < NL;
        if (lat) { b = r >> 12; t = r & 4095; kvrow = b * KVS + CTXL + t; } else { b = (r - NL) >> 8; t = (r - NL) & 255; kvrow = b * KVS + t; }
        v4u zq[3], zk = zkn, zr = zrn; f32x4 tb[4];
#pragma unroll
        for (int jj = 0; jj < 3; ++jj) zq[jj] = zqn[jj];
#pragma unroll
        for (int q = 0; q < 4; ++q) tb[q] = tbn[q];
        asm volatile("" : "+v"(zq[0]), "+v"(zq[1]), "+v"(zq[2]), "+v"(zk), "+v"(zr), "+v"(tb[0]), "+v"(tb[1]), "+v"(tb[2]), "+v"(tb[3]) :: "memory");
        { const int rn = (r + NGW < R0) ? r + NGW : r; MN_LOAD(rn); }
        asm volatile("" ::: "memory");
        if (lat) {
            float q[24]; float ss = 0.f;
#pragma unroll
            for (int jj = 0; jj < 3; ++jj) { const v4u z = zq[jj];
#pragma unroll
                for (int e = 0; e < 8; ++e) { const float x = (e & 1) ? bfhi(z[e >> 1]) : bflo(z[e >> 1]); q[jj * 8 + e] = x; ss += x * x; } }
            const float rstd = 1.f / sqrtf(wave_sum(ss) * (1.f / 1536.f) + RMS_EPS);
#pragma unroll
            for (int jj = 0; jj < 3; ++jj) { v4u w; w.x = pk2(q[jj * 8 + 0] * rstd, q[jj * 8 + 1] * rstd); w.y = pk2(q[jj * 8 + 2] * rstd, q[jj * 8 + 3] * rstd); w.z = pk2(q[jj * 8 + 4] * rstd, q[jj * 8 + 5] * rstd); w.w = pk2(q[jj * 8 + 6] * rstd, q[jj * 8 + 7] * rstd);
                *(GAS v4u*)(QN + (size_t)r * 1536 + jj * 512 + F.lane * 8) = w; }
        }
        {
            const v4u z = zk; float kv[8]; float ss = 0.f;
#pragma unroll
            for (int e = 0; e < 8; ++e) { const float x = (e & 1) ? bfhi(z[e >> 1]) : bflo(z[e >> 1]); kv[e] = x; ss += x * x; }
            const float rstd = 1.f / sqrtf(wave_sum(ss) * (1.f / 512.f) + RMS_EPS);
            v4u w; w.x = pk2(kv[0] * rstd, kv[1] * rstd); w.y = pk2(kv[2] * rstd, kv[3] * rstd); w.z = pk2(kv[4] * rstd, kv[5] * rstd); w.w = pk2(kv[6] * rstd, kv[7] * rstd);
            *(GAS v4u*)(KVN + (size_t)kvrow * 512 + F.lane * 8) = w;
        }
        {
            const v4u z = zr; float x[8], px[8];
#pragma unroll
            for (int e = 0; e < 8; ++e) x[e] = (e & 1) ? bfhi(z[e >> 1]) : bflo(z[e >> 1]);
#pragma unroll
            for (int e = 0; e < 8; ++e) px[e] = dpp_mov<0x4E>(x[e]);
            float o[8];
            if (lat) { const bool second = (l & 2) != 0;
#pragma unroll
                for (int q = 0; q < 4; ++q) { const f32x4 t4 = tb[q];
                    o[2 * q] = second ? (x[2 * q] * t4.x + px[2 * q] * t4.y) : (x[2 * q] * t4.x - px[2 * q] * t4.y);
                    o[2 * q + 1] = second ? (x[2 * q + 1] * t4.z + px[2 * q + 1] * t4.w) : (x[2 * q + 1] * t4.z - px[2 * q + 1] * t4.w); } }
            else {
#pragma unroll
                for (int e = 0; e < 8; ++e) o[e] = x[e]; }
            if (F.lane < 8) { v4u w; w.x = pk2(o[0], o[1]); w.y = pk2(o[2], o[3]); w.z = pk2(o[4], o[5]); w.w = pk2(o[6], o[7]); *(GAS v4u*)(KPE + (size_t)kvrow * 64 + l * 8) = w; }
        }
    }
#undef MN_LOAD
}
namespace ml {
constexpr int L = 64, DVS = 32, QP = 528, VP = 80, PP = 144;
constexpr int CTB = 34 * QP;
constexpr int O_Q = 0, O_K = 33792, O_CT = 67584, O_V = O_CT + 2 * CTB, O_VW = O_V + 64 * VP, O_P = O_VW + 64 * VP, O_SC = O_P + 64 * PP;
constexpr int S_A = 0, S_M = 64, S_WI = 128, S_CL = 192, S_WG = 256, S_DEC = 320, SCB = 328;
static_assert(O_SC + 2 * SCB * 4 <= LDSCTL_OFF && O_CT + CTB + 48 * QP <= LDSCTL_OFF, "mlstm LDS map");
__device__ __forceinline__ float log_sigmoid(float x) { return fminf(x, 0.f) - __logf(1.f + __expf(-fabsf(x))); }
typedef short v4i16_t __attribute__((ext_vector_type(4)));
__device__ __forceinline__ s16x4 trr(const LAS unsigned char* p) { return __builtin_bit_cast(s16x4, __builtin_amdgcn_ds_read_tr16_b64_v4i16((LAS v4i16_t*)p)); }
__device__ __forceinline__ bf16x8 cat(s16x4 lo, s16x4 hi) { return (bf16x8){lo[0], lo[1], lo[2], lo[3], hi[0], hi[1], hi[2], hi[3]}; }
__device__ __forceinline__ unsigned cvtpk(float lo, float hi) { unsigned r; asm volatile("v_cvt_pk_bf16_f32 %0, %1, %2" : "=v"(r) : "v"(lo), "v"(hi)); return r; }
template <int CTRL, int ROWMASK> __device__ __forceinline__ float dpp_f(float old, float v) { return __uint_as_float((unsigned)__builtin_amdgcn_update_dpp((int)__float_as_uint(old), (int)__float_as_uint(v), CTRL, ROWMASK, 0xF, false)); }
__device__ __forceinline__ float scan_add64(float v) {
    v += dpp_f<0x111, 0xF>(0.f, v); v += dpp_f<0x112, 0xF>(0.f, v); v += dpp_f<0x114, 0xF>(0.f, v); v += dpp_f<0x118, 0xF>(0.f, v);
    v += dpp_f<0x142, 0xA>(0.f, v); v += dpp_f<0x143, 0xC>(0.f, v); return v;
}
__device__ __forceinline__ float scan_max64(float v) {
    const float ninf = -__builtin_inff();
    v = fmaxf(v, dpp_f<0x111, 0xF>(ninf, v)); v = fmaxf(v, dpp_f<0x112, 0xF>(ninf, v)); v = fmaxf(v, dpp_f<0x114, 0xF>(ninf, v)); v = fmaxf(v, dpp_f<0x118, 0xF>(ninf, v));
    v = fmaxf(v, dpp_f<0x142, 0xA>(ninf, v)); v = fmaxf(v, dpp_f<0x143, 0xC>(ninf, v)); return v;
}
__device__ __forceinline__ float rdlane63(float v) { return __uint_as_float((unsigned)__builtin_amdgcn_readlane((int)__float_as_uint(v), 63)); }
__device__ __forceinline__ int row_of(int step, int i, int dir, int bb) {
    const bool isctx = step < 4; const int T = isctx ? CTXL : SEQ, p = (isctx ? step : step - 4) * L + i, t = dir ? T - 1 - p : p;
    return (isctx ? NL + bb * CTXL : bb * SEQ) + t;
}

__device__ __forceinline__ void mlstm_task(Frame& F, const Args& A, int task) {
    const int dvs = task & 7, hh = (task >> 3) & 3, bb = (task >> 5) & 3, dir = task >> 7;
    LAS unsigned char* lds = F.lds;
    int tid = F.tid; asm volatile("" : "+v"(tid));
    const int lane = tid & 63, w = F.wave, fr = lane & 15, fq = lane >> 4;
    const bf16* QK = WSP(bf16, WS_QK); const bf16* PB = WSP(bf16, WS_PB); const float* GT = WSP(float, WS_GATES);
    bf16* HO = WSP(bf16, WS_HF) + (size_t)dir * R0 * 1024;
    __syncthreads();
    for (int i = tid; i < (2 * CTB) / 4; i += 512) ((LAS unsigned*)(lds + O_CT))[i] = 0u;
    for (int i = tid; i < (2 * 64 * VP) / 4; i += 512) ((LAS unsigned*)(lds + O_V))[i] = 0u;
    __syncthreads();
    if (tid < 64) *(LAS unsigned short*)(lds + O_V + tid * VP + 64) = (unsigned short)0x3F80u;
    f32x4 cacc[2][3];
#pragma unroll
    for (int b = 0; b < 2; ++b)
#pragma unroll
        for (int a = 0; a < 3; ++a) cacc[b][a] = (f32x4){0.f, 0.f, 0.f, 0.f};
    float m_prev = 0.f;
    v4u qn_[4], kn_[4], vn_ = (v4u){0u, 0u, 0u, 0u}; float lin = 0.f, fgn = 0.f;
#define ML_PREFETCH(st) do { if (w == 0) { const size_t gr_ = (size_t)row_of((st), lane, dir, bb) * 16 + dir * 8 + hh; lin = GT[gr_]; fgn = GT[gr_ + 4]; } \
        const size_t row_ = (size_t)row_of((st), tid >> 3, dir, bb); const bf16* qrow_ = QK + row_ * 2048 + hh * 256; \
        _Pragma("unroll") for (int j = 0; j < 4; ++j) { const int col_ = j * 64 + (tid & 7) * 8; qn_[j] = *(const GAS v4u*)(qrow_ + col_); kn_[j] = *(const GAS v4u*)(qrow_ + 1024 + col_); } \
        if (tid < 256) vn_ = *(const GAS v4u*)(PB + (size_t)row_of((st), tid >> 2, dir, bb) * PW + 2048 + hh * 256 + dvs * DVS + (tid & 3) * 8); } while (0)
#define ML_SCALARS(par) do { LAS float* sc_ = (LAS float*)(lds + O_SC) + (par) * SCB; \
        const float bcs = scan_add64(log_sigmoid(fgn)); const float a_ = lin - bcs; const float pm = scan_max64(a_); \
        const float M_ = fmaxf(m_prev, pm); const float Mc = rdlane63(M_), bl = rdlane63(bcs); \
        sc_[S_A + lane] = a_; sc_[S_M + lane] = M_; sc_[S_WI + lane] = __expf(m_prev - M_); sc_[S_CL + lane] = __expf(-bcs - M_); sc_[S_WG + lane] = __expf(a_ - Mc); \
        if (lane == 0) sc_[S_DEC] = __expf(m_prev - Mc); \
        m_prev = bl + Mc; } while (0)
#define ML_BAR() do { asm volatile("s_waitcnt lgkmcnt(0)" ::: "memory"); __builtin_amdgcn_s_barrier(); asm volatile("" ::: "memory"); } while (0)
    float cvv[32];
    ML_PREFETCH(0);
    if (w == 0) ML_SCALARS(0);
    int cur = 0;
    for (int step = 0; step < 68; ++step) {
        const LAS float* sc = (const LAS float*)(lds + O_SC) + (step & 1) * SCB;
        {
            const int i = tid >> 3;
#pragma unroll
            for (int j = 0; j < 4; ++j) { const int col = j * 64 + (tid & 7) * 8; *(LAS v4u*)(lds + O_Q + i * QP + col * 2) = qn_[j]; *(LAS v4u*)(lds + O_K + i * QP + col * 2) = kn_[j]; }
        }
        const v4u vcur = vn_;
        if (tid < 256) *(LAS v4u*)(lds + O_V + (tid >> 2) * VP + (tid & 3) * 16) = vcur;
        if (step + 1 < 68) ML_PREFETCH(step + 1);
        const MoeItem cvi = moe_item(F, A, moe_scan_m(((step < MOE_SCAN_STEPS ? step : 0) * 256 + task) * 8 + w)); if (step < MOE_SCAN_STEPS) cv_issue(cvv, cvi.src, 2048, cvi.k0, cvi.n0, lane);
        ML_BAR();
        if (tid < 256) { const float wg = sc[S_WG + (tid >> 2)]; v4u ww;
#pragma unroll
            for (int e = 0; e < 4; ++e) ww[e] = cvtpk(bflo(vcur[e]) * wg, bfhi(vcur[e]) * wg);
            *(LAS v4u*)(lds + O_VW + (tid >> 2) * VP + (tid & 3) * 16) = ww;
            if ((tid & 3) == 0) *(LAS unsigned short*)(lds + O_VW + (tid >> 2) * VP + 64) = (unsigned short)f2bf(wg); }
        {
            const int t0 = 16 * (w >> 1), t = t0 + fr; const float Mt = sc[S_M + t];
            f32x4 acc[2] = {(f32x4){0.f, 0.f, 0.f, 0.f}, (f32x4){0.f, 0.f, 0.f, 0.f}};
#pragma unroll
            for (int kk = 0; kk < 8; ++kk) {
                const bf16x8 qf = *(const LAS bf16x8*)(lds + O_Q + (t0 + fr) * QP + (kk * 32 + 8 * fq) * 2);
#pragma unroll
                for (int ct = 0; ct < 2; ++ct) { const int s0 = 32 * (w & 1) + 16 * ct;
                    if (s0 <= t0) { const bf16x8 kf = *(const LAS bf16x8*)(lds + O_K + (s0 + fr) * QP + (kk * 32 + 8 * fq) * 2);
                        acc[ct] = __builtin_amdgcn_mfma_f32_16x16x32_bf16(kf, qf, acc[ct], 0, 0, 0); } }
            }
#pragma unroll
            for (int ct = 0; ct < 2; ++ct) { const int s0 = 32 * (w & 1) + 16 * ct, sb = s0 + 4 * fq;
                const f32x4 av = *(const LAS f32x4*)(sc + S_A + sb); float pv[4];
#pragma unroll
                for (int e = 0; e < 4; ++e) pv[e] = (sb + e <= t) ? acc[ct][e] * __expf(av[e] - Mt) : 0.f;
                v2u pw; pw.x = cvtpk(pv[0], pv[1]); pw.y = cvtpk(pv[2], pv[3]);
                *(LAS v2u*)(lds + O_P + t * PP + sb * 2) = pw; }
        }
        ML_BAR();
        {
            const int t0 = 16 * (w >> 1), d0 = 16 * (w & 1), t = t0 + fr;
            const LAS unsigned char* ct = lds + O_CT + cur * CTB;
            f32x4 aC = (f32x4){0.f, 0.f, 0.f, 0.f}, aV = aC, dC = aC, dV = aC;
#pragma unroll
            for (int kk = 0; kk < 8; ++kk) {
                const bf16x8 qf = *(const LAS bf16x8*)(lds + O_Q + (t0 + fr) * QP + (kk * 32 + 8 * fq) * 2);
                const bf16x8 cf = *(const LAS bf16x8*)(ct + (d0 + fr) * QP + (kk * 32 + 8 * fq) * 2);
                const bf16x8 nf = *(const LAS bf16x8*)(ct + (32 + fr) * QP + (kk * 32 + 8 * fq) * 2);
                aC = __builtin_amdgcn_mfma_f32_16x16x32_bf16(cf, qf, aC, 0, 0, 0);
                dC = __builtin_amdgcn_mfma_f32_16x16x32_bf16(nf, qf, dC, 0, 0, 0);
            }
#pragma unroll
            for (int kk = 0; kk < 2; ++kk) {
                const bf16x8 pf = *(const LAS bf16x8*)(lds + O_P + (t0 + fr) * PP + (kk * 32 + 8 * fq) * 2);
                const LAS unsigned char* vb = lds + O_V + (kk * 32 + 8 * fq + (fr >> 2)) * VP + (d0 + 4 * (fr & 3)) * 2;
                const LAS unsigned char* v1 = lds + O_V + (kk * 32 + 8 * fq + (fr >> 2)) * VP + (32 + 4 * (fr & 3)) * 2;
                const bf16x8 vf = cat(trr(vb), trr(vb + 4 * VP)), of = cat(trr(v1), trr(v1 + 4 * VP));
                aV = __builtin_amdgcn_mfma_f32_16x16x32_bf16(vf, pf, aV, 0, 0, 0);
                dV = __builtin_amdgcn_mfma_f32_16x16x32_bf16(of, pf, dV, 0, 0, 0);
            }
            const float wi = sc[S_WI + t];
            const float den = __shfl(wi * dC[0] + dV[0], fr);
            const float rinv = 1.f / fmaxf(fabsf(den), sc[S_CL + t]);
            f32x4 hv;
#pragma unroll
            for (int e = 0; e < 4; ++e) hv[e] = (wi * aC[e] + aV[e]) * rinv;
            { v2u hw; hw.x = cvtpk(hv[0], hv[1]); hw.y = cvtpk(hv[2], hv[3]); *(GAS v2u*)(HO + (size_t)row_of(step, t, dir, bb) * 1024 + hh * 256 + dvs * DVS + d0 + 4 * fq) = hw; }
            const float dec = sc[S_DEC];
#pragma unroll
            for (int b = 0; b < 2; ++b)
#pragma unroll
                for (int a = 0; a < 3; ++a) cacc[b][a] = cacc[b][a] * dec;
#pragma unroll
            for (int kk = 0; kk < 2; ++kk) {
                bf16x8 vf[3];
#pragma unroll
                for (int a = 0; a < 3; ++a) { const LAS unsigned char* vb = lds + O_VW + (kk * 32 + 8 * fq + (fr >> 2)) * VP + (16 * a + 4 * (fr & 3)) * 2; vf[a] = cat(trr(vb), trr(vb + 4 * VP)); }
#pragma unroll
                for (int b = 0; b < 2; ++b) { const LAS unsigned char* kb = lds + O_K + (kk * 32 + 8 * fq + (fr >> 2)) * QP + (32 * w + 16 * b + 4 * (fr & 3)) * 2; const bf16x8 kf = cat(trr(kb), trr(kb + 4 * QP));
#pragma unroll
                    for (int a = 0; a < 3; ++a) cacc[b][a] = __builtin_amdgcn_mfma_f32_16x16x32_bf16(kf, vf[a], cacc[b][a], 0, 0, 0); }
            }
            LAS unsigned char* cn = lds + O_CT + (cur ^ 1) * CTB;
#pragma unroll
            for (int b = 0; b < 2; ++b) { const int dk = 32 * w + 16 * b + 4 * fq;
#pragma unroll
                for (int a = 0; a < 2; ++a) { v2u pw; pw.x = cvtpk(cacc[b][a][0], cacc[b][a][1]); pw.y = cvtpk(cacc[b][a][2], cacc[b][a][3]); *(LAS v2u*)(cn + (16 * a + fr) * QP + dk * 2) = pw; }
                if (fr == 0) { v2u pw; pw.x = cvtpk(cacc[b][2][0], cacc[b][2][1]); pw.y = cvtpk(cacc[b][2][2], cacc[b][2][3]); *(LAS v2u*)(cn + 32 * QP + dk * 2) = pw; } }
            if (w == 0 && step + 1 < 68) ML_SCALARS((step + 1) & 1);
        }
        if (step < MOE_SCAN_STEPS) cv_finish(cvv, cvi.dst, 32, cvi.dr0, cvi.k0, nullptr, lane);
        ML_BAR();
        cur ^= 1;
    }
    __syncthreads();
#undef ML_BAR
#undef ML_SCALARS
#undef ML_PREFETCH
}
}

__device__ __forceinline__ unsigned block_excl_scan(Frame& F, const Args& A, unsigned v, LAS unsigned* wsum, unsigned& total) {
    unsigned x = v;
#pragma unroll
    for (int o = 1; o < 64; o <<= 1) { const unsigned y = __shfl_up(x, o); if (F.lane >= o) x += y; }
    __syncthreads();
    if (F.lane == 63) wsum[F.wave] = x;
    __syncthreads();
    unsigned base = 0, tot = 0;
#pragma unroll
    for (int q = 0; q < 8; ++q) { const unsigned s = wsum[q]; if (q < F.wave) base += s; tot += s; }
    total = tot;
    return base + x - v;
}
__device__ __forceinline__ void topk_problem(Frame& F, const Args& A, int prob, int slots, bool padl1 = false) {
    const bool isctx = prob >= 64; const int q = prob & 63, b = q >> 4, e = q & 15;
    const int T = isctx ? CTXL : SEQ, cap = isctx ? CAPC : CAPL, rbase = isctx ? NL + b * CTXL : b * SEQ, sbase = isctx ? 2048 + b * CAPC : b * CAPL;
    LAS unsigned* keys = (LAS unsigned*)F.lds;
    LAS unsigned* hist = keys + 4096;
    LAS unsigned* wsum = hist + 256;
    LAS unsigned* sel = wsum + 8;
    const float* AFF = WSP(float, WS_AFF); int* RIDX = WSP(int, WS_RIDX); float* RGATE = WSP(float, WS_RGATE); int* RSLOT = WSP(int, WS_RSLOT);
    __syncthreads();
    for (int i = F.tid; i < T; i += 512) keys[i] = __float_as_uint(AFF[(size_t)(rbase + i) * 16 + e]);
    unsigned prefix = 0u, kleft = (unsigned)cap;
    for (int pass = 0; pass < 4; ++pass) {
        const int shift = 24 - 8 * pass;
        if (F.tid < 256) hist[F.tid] = 0u;
        __syncthreads();
        for (int i = F.tid; i < T; i += 512) { const unsigned k = keys[i]; const bool match = (pass == 0) || ((k >> (shift + 8)) == prefix); if (match) __hip_atomic_fetch_add(&hist[(k >> shift) & 255u], 1u, __ATOMIC_RELAXED, __HIP_MEMORY_SCOPE_WORKGROUP); }
        __syncthreads();
        if (F.tid < 64) {
            unsigned c[4], s = 0u;
#pragma unroll
            for (int j = 0; j < 4; ++j) { c[j] = hist[255 - (F.lane * 4 + j)]; s += c[j]; }
            unsigned incl = s;
#pragma unroll
            for (int o = 1; o < 64; o <<= 1) { const unsigned y = __shfl_up(incl, o); if (F.lane >= o) incl += y; }
            const unsigned before = incl - s;
            if (before < kleft && incl >= kleft) {
                unsigned accb = before; bool found = false;
#pragma unroll
                for (int j = 0; j < 4; ++j) { if (!found) { if (accb + c[j] >= kleft) { sel[0] = (prefix << 8) | (unsigned)(255 - (F.lane * 4 + j)); sel[1] = kleft - accb; found = true; } else accb += c[j]; } }
            }
        }
        __syncthreads();
        prefix = sel[0]; kleft = sel[1];
        __syncthreads();
    }
    const unsigned thr = prefix;
    const int per = T / 512 > 0 ? T / 512 : 1; const int i0 = F.tid * per; const bool act = i0 < T;
    unsigned ngt = 0u, neq = 0u;
    for (int j = 0; j < per; ++j) if (act) { const unsigned k = keys[i0 + j]; ngt += (k > thr) ? 1u : 0u; neq += (k == thr) ? 1u : 0u; }
    unsigned tot_gt, tot_eq;
    unsigned pgt = block_excl_scan(F, A, ngt, wsum, tot_gt);
    unsigned peq = block_excl_scan(F, A, neq, wsum, tot_eq);
    for (int j = 0; j < per; ++j) if (act) {
        const int i = i0 + j; const unsigned k = keys[i]; int slot = -1;
        if (k > thr) { slot = (int)pgt; ++pgt; }
        else if (k == thr) { if (peq < kleft) slot = (int)(tot_gt + peq); ++peq; }
        RSLOT[(size_t)(rbase + i) * 16 + e] = (slot >= 0) ? sbase + slot : -1;
        if (slot >= 0) { RIDX[e * slots + sbase + slot] = rbase + i; RGATE[e * slots + sbase + slot] = __uint_as_float(k); }
    }
    if (isctx && b == 0 && F.tid < 128) { RIDX[e * slots + 2176 + F.tid] = e * 128 + F.tid; RGATE[e * slots + 2176 + F.tid] = 0.f; }
#ifdef EXP_L1_NINE
    if (!isctx && b == 0 && slots == 2304 && F.tid < 256 && padl1) { RIDX[e * slots + 2048 + F.tid] = e * 256 + F.tid; RGATE[e * slots + 2048 + F.tid] = 0.f; }
#endif
    __syncthreads();
}
namespace at {
constexpr int NW = 8, QBLK = 32, KVBLK = 64;
#ifndef NQR
#define NQR 8
#endif
constexpr float SCALE = 0.07216878364870322f;
constexpr float THR = 8.f;
constexpr int LDQ = 3072, LDK = 4096, LDP = 64, LDO = 2048;
constexpr int SHM_V = KVBLK * 128 * 2, SHM_K = KVBLK * 128 * 2, SHM_P = KVBLK * 64 * 2;
constexpr int O_V = 0, O_K = 2 * SHM_V, O_PE = O_K + 2 * SHM_K, O_WS = O_PE + 2 * SHM_P, O_QP = O_WS + NW * 64 * 4, SHM_ATTN = O_QP + NW * 6 * 1024;
#define KSWZ(row, colB) ((row) * 256 + ((colB) ^ (((row) & 7) << 4)))
#define PSWZ(row, colB) ((row) * 128 + ((colB) ^ ((((row) >> 1) & 7) << 4)))
#define SBAR() __builtin_amdgcn_sched_barrier(0)
__device__ __forceinline__ int crow(int r, int hi) { return (r & 3) + 8 * (r >> 2) + 4 * hi; }
__device__ __forceinline__ unsigned cvtpk(float lo, float hi) { unsigned r; asm volatile("v_cvt_pk_bf16_f32 %0, %1, %2" : "=v"(r) : "v"(lo), "v"(hi)); return r; }
__device__ __forceinline__ void partialSM(f32x16& p0, f32x16& p1, float& m_reg, float& mn, float& alpha) {
  constexpr float C = SCALE * 1.4426950408889634f;
  float pmax = p0[0];
#pragma unroll
  for (int r = 1; r < 16; ++r) pmax = fmaxf(pmax, p0[r]);
#pragma unroll
  for (int r = 0; r < 16; ++r) pmax = fmaxf(pmax, p1[r]);
  { auto rr = __builtin_amdgcn_permlane32_swap(__float_as_uint(pmax), __float_as_uint(pmax), false, false);
    pmax = fmaxf(__uint_as_float(rr[0]), __uint_as_float(rr[1])); }
  if (__builtin_expect(__all(pmax - m_reg <= THR / SCALE), 1)) { mn = m_reg; alpha = 1.f; }
  else { mn = fmaxf(m_reg, pmax); alpha = __builtin_amdgcn_exp2f((m_reg - mn) * C); m_reg = mn; }
  float mnC = -mn * C;
#pragma unroll
  for (int r = 0; r < 16; ++r) p0[r] = fmaf(p0[r], C, mnC);
#pragma unroll
  for (int r = 0; r < 16; ++r) p1[r] = fmaf(p1[r], C, mnC);
#pragma unroll
  for (int r = 0; r < 16; ++r) p0[r] = __builtin_amdgcn_exp2f(p0[r]);
}
__device__ __forceinline__ void finishSM(f32x16& p0, f32x16& p1, float alpha, float& l_reg, bf16x8& pa0, bf16x8& pa1, bf16x8& pa2, bf16x8& pa3) {
#pragma unroll
  for (int r = 0; r < 16; ++r) p1[r] = __builtin_amdgcn_exp2f(p1[r]);
  float ps = 0;
#pragma unroll
  for (int r = 0; r < 16; ++r) ps += p0[r];
#pragma unroll
  for (int r = 0; r < 16; ++r) ps += p1[r];
  { auto rr = __builtin_amdgcn_permlane32_swap(__float_as_uint(ps), __float_as_uint(ps), false, false);
    ps = __uint_as_float(rr[0]) + __uint_as_float(rr[1]); }
  l_reg = l_reg * alpha + ps;
#define PK4(P, BASE, OUT) do { unsigned a0 = cvtpk(P[BASE + 0], P[BASE + 1]), a1 = cvtpk(P[BASE + 2], P[BASE + 3]);   \
    unsigned b0 = cvtpk(P[BASE + 4], P[BASE + 5]), b1 = cvtpk(P[BASE + 6], P[BASE + 7]);                              \
    auto r0 = __builtin_amdgcn_permlane32_swap(a0, b0, false, false); auto r1 = __builtin_amdgcn_permlane32_swap(a1, b1, false, false); \
    v4u w = {r0[0], r1[0], r0[1], r1[1]}; OUT = *reinterpret_cast<bf16x8*>(&w); } while (0)
  PK4(p0, 0, pa0); PK4(p0, 8, pa1); PK4(p1, 0, pa2); PK4(p1, 8, pa3);
#undef PK4
}
__device__ __forceinline__ void qkt(f32x16& p0, f32x16& p1, const char* Ks, const char* Ps, const bf16x8* qr, const char* qp, int r32, int hi) {
  p0 = f32x16{}; p1 = f32x16{};
#pragma unroll
  for (int d0 = 0; d0 < 8; ++d0) { int cb = (d0 * 16 + hi * 8) * 2;
    bf16x8 b0 = *reinterpret_cast<const bf16x8*>(Ks + KSWZ(r32, cb));
    bf16x8 b1 = *reinterpret_cast<const bf16x8*>(Ks + KSWZ(32 + r32, cb));
    const bf16x8 qv = (d0 < NQR) ? qr[d0 < NQR ? d0 : 0] : *reinterpret_cast<const bf16x8*>(qp + (d0 - NQR < 0 ? 0 : d0 - NQR) * 1024);
    p0 = __builtin_amdgcn_mfma_f32_32x32x16_bf16(b0, qv, p0, 0, 0, 0);
    p1 = __builtin_amdgcn_mfma_f32_32x32x16_bf16(b1, qv, p1, 0, 0, 0); }
#pragma unroll
  for (int d0 = 0; d0 < 4; ++d0) { int cb = (d0 * 16 + hi * 8) * 2;
    bf16x8 b0 = *reinterpret_cast<const bf16x8*>(Ps + PSWZ(r32, cb));
    bf16x8 b1 = *reinterpret_cast<const bf16x8*>(Ps + PSWZ(32 + r32, cb));
    const bf16x8 qv = (8 + d0 < NQR) ? qr[8 + d0 < NQR ? 8 + d0 : 0] : *reinterpret_cast<const bf16x8*>(qp + (8 + d0 - NQR < 0 ? 0 : 8 + d0 - NQR) * 1024);
    p0 = __builtin_amdgcn_mfma_f32_32x32x16_bf16(b0, qv, p0, 0, 0, 0);
    p1 = __builtin_amdgcn_mfma_f32_32x32x16_bf16(b1, qv, p1, 0, 0, 0); }
}
__device__ __forceinline__ int v_st(int k, int c) { const int kk = (k & ~0xC) | ((k & 4) << 1) | ((k & 8) >> 1); return ((kk >> 3) * 4 + (c >> 5)) * 512 + ((kk & 7) * 32 + (c & 31)) * 2; }
__device__ __forceinline__ int v_rd_base(int lane) { return ((lane & 3) << 3) | (((lane >> 2) & 3) << 6) | (((lane >> 4) & 1) << 5) | (((lane >> 5) & 1) << 8); }
constexpr int v_rd_off(int d0, int ks, int half) { return d0 * 512 + ks * 4096 + half * 2048; }
template <int OFF> __device__ __forceinline__ s16x4 tr_read(int vb) {
  s16x4 r; asm volatile("ds_read_b64_tr_b16 %0, %1 offset:%2" : "=&v"(r) : "v"(vb), "i"(OFF) : "memory"); return r;
}
template <int D0> __device__ __forceinline__ void pv_one(f32x16& od, int vb, bf16x8 pa0, bf16x8 pa1, bf16x8 pa2, bf16x8 pa3) {
  const s16x4 l0 = tr_read<v_rd_off(D0, 0, 0)>(vb), h0 = tr_read<v_rd_off(D0, 0, 1)>(vb), l1 = tr_read<v_rd_off(D0, 1, 0)>(vb), h1 = tr_read<v_rd_off(D0, 1, 1)>(vb);
  const s16x4 l2 = tr_read<v_rd_off(D0, 2, 0)>(vb), h2 = tr_read<v_rd_off(D0, 2, 1)>(vb), l3 = tr_read<v_rd_off(D0, 3, 0)>(vb), h3 = tr_read<v_rd_off(D0, 3, 1)>(vb);
  asm volatile("s_waitcnt lgkmcnt(0)" ::: "memory"); SBAR();
#define PK(L, H) (bf16x8){L[0], L[1], L[2], L[3], H[0], H[1], H[2], H[3]}
  od = __builtin_amdgcn_mfma_f32_32x32x16_bf16(pa0, PK(l0, h0), od, 0, 0, 0);
  od = __builtin_amdgcn_mfma_f32_32x32x16_bf16(pa1, PK(l1, h1), od, 0, 0, 0);
  od = __builtin_amdgcn_mfma_f32_32x32x16_bf16(pa2, PK(l2, h2), od, 0, 0, 0);
  od = __builtin_amdgcn_mfma_f32_32x32x16_bf16(pa3, PK(l3, h3), od, 0, 0, 0);
#undef PK
}
__device__ __forceinline__ void pv_d0(f32x16* o, int vb, bf16x8 pa0, bf16x8 pa1, bf16x8 pa2, bf16x8 pa3) {
  pv_one<0>(o[0], vb, pa0, pa1, pa2, pa3); pv_one<1>(o[1], vb, pa0, pa1, pa2, pa3); pv_one<2>(o[2], vb, pa0, pa1, pa2, pa3); pv_one<3>(o[3], vb, pa0, pa1, pa2, pa3);
}
__device__ __forceinline__ void attn_unit(const bf16* Qb, const bf16* Kh, const bf16* Vh, const bf16* Kp, bf16* Ob, int seq, char* lds, Frame& F, const Args& A, int cvbase) {
  int tid = threadIdx.x; asm volatile("" : "+v"(tid));
  const int wid = tid >> 6, lane = tid & 63, r32 = lane & 31, hi = lane >> 5;
  char* V_lds = lds + O_V; char* K_lds = lds + O_K; char* P_lds = lds + O_PE;
  float* ws = (float*)(lds + O_WS) + wid * 64; float* li_l = ws; float* al_l = ws + 32;
  float m_reg = -1e30f, l_reg = 0; f32x16 o[4] = {}; bf16x8 qr[NQR];
  const bf16* Qw = Qb + (long)(wid * QBLK + r32) * LDQ + hi * 8;
#pragma unroll
  for (int d0 = 0; d0 < NQR; ++d0) qr[d0] = *reinterpret_cast<const bf16x8*>(Qw + d0 * 16);
  char* qp = lds + O_QP + wid * 6144 + lane * 16;
#pragma unroll
  for (int f = NQR; f < 12; ++f) *reinterpret_cast<bf16x8*>(qp + (f - NQR) * 1024) = *reinterpret_cast<const bf16x8*>(Qw + f * 16);
  const int vb0 = (int)(uintptr_t)V_lds + v_rd_base(lane);
  const int widu = __builtin_amdgcn_readfirstlane(tid >> 6);
  unsigned gk[2], gv[2], gp;
#pragma unroll
  for (int i = 0; i < 2; ++i) { const int q = widu * 2 + i;
    { const int row = 4 * q + (lane >> 4), pch = lane & 15; gk[i] = (unsigned)(row * LDK + ((pch ^ (row & 7)) * 8)); }
    { const int jch = q * 64 + lane, blk = jch >> 5, ch = jch & 31, kk = (blk >> 2) * 8 + (ch >> 2), c = (blk & 3) * 32 + (ch & 3) * 8;
      const int k = (kk & ~0xC) | ((kk & 4) << 1) | ((kk & 8) >> 1); gv[i] = (unsigned)(k * LDK + c); } }
  { const int jch = widu * 64 + lane, row = jch >> 3, pch = jch & 7; gp = (unsigned)(row * LDP + ((pch ^ ((row >> 1) & 7)) * 8)); }
  typedef __attribute__((address_space(3))) unsigned las_u32;
  const unsigned ldsK = (unsigned)(uintptr_t)K_lds + widu * 2048u, ldsV = (unsigned)(uintptr_t)V_lds + widu * 2048u, ldsP = (unsigned)(uintptr_t)P_lds + widu * 1024u;
#define DMA_KP(t, b) do { const bf16* Kt_ = Kh + (long)(t) * KVBLK * LDK; const bf16* Pt_ = Kp + (long)(t) * KVBLK * LDP; \
    __builtin_amdgcn_global_load_lds((const unsigned*)(Kt_ + gk[0]), (las_u32*)(ldsK + (b) * SHM_K), 16, 0, 0); \
    __builtin_amdgcn_global_load_lds((const unsigned*)(Kt_ + gk[1]), (las_u32*)(ldsK + (b) * SHM_K + 1024u), 16, 0, 0); \
    __builtin_amdgcn_global_load_lds((const unsigned*)(Pt_ + gp), (las_u32*)(ldsP + (b) * SHM_P), 16, 0, 0); } while (0)
#define DMA_V(t, b) do { const bf16* Vt_ = Vh + (long)(t) * KVBLK * LDK; \
    __builtin_amdgcn_global_load_lds((const unsigned*)(Vt_ + gv[0]), (las_u32*)(ldsV + (b) * SHM_V), 16, 0, 0); \
    __builtin_amdgcn_global_load_lds((const unsigned*)(Vt_ + gv[1]), (las_u32*)(ldsV + (b) * SHM_V + 1024u), 16, 0, 0); } while (0)
#define DWAIT() asm volatile("s_waitcnt vmcnt(0)" ::: "memory")
#define RESC(a) do { if (__any((a) < 1.f)) { if (hi == 0) al_l[r32] = (a); asm volatile("s_waitcnt lgkmcnt(0)" ::: "memory"); \
    _Pragma("unroll") for (int d = 0; d < 4; ++d) _Pragma("unroll") for (int r = 0; r < 16; ++r) o[d][r] *= al_l[crow(r, hi)]; } } while (0)
  f32x16 pA0, pA1, pB0, pB1; float mnA, mnB, alA, alB; bf16x8 pa0, pa1, pa2, pa3; const int NT = seq / KVBLK; float cvh[16];
  DMA_KP(0, 0); DMA_V(0, 0); DMA_KP(1, 1); DWAIT(); __syncthreads();
  qkt(pA0, pA1, K_lds, P_lds, qr, qp, r32, hi); partialSM(pA0, pA1, m_reg, mnA, alA);
  __syncthreads();
  for (int j = 1; j + 1 < NT; j += 2) {
    DMA_KP(j + 1, 0); DMA_V(j, 1);
    const bool cvon = cvbase >= 0 && (j >> 1) < CVA_PER_UNIT; const int cvidx = cvbase + (j >> 1) * 2048;
    if (cvon) { const MoeItem ci = moe_item(F, A, moe_l1_m(cvidx >> 1)); cvs_issue(cvh, ci.src, 2048, ci.k0 + 32 * (cvidx & 1), ci.n0, lane); }
    SBAR(); qkt(pB0, pB1, K_lds + SHM_K, P_lds + SHM_P, qr, qp, r32, hi);
    finishSM(pA0, pA1, alA, l_reg, pa0, pa1, pa2, pa3); SBAR();
    pv_d0(o, vb0, pa0, pa1, pa2, pa3); partialSM(pB0, pB1, m_reg, mnB, alB);
    RESC(alB); DWAIT(); __syncthreads();
    if (cvon) { const MoeItem ci = moe_item(F, A, moe_l1_m(cvidx >> 1)); cvs_finish(cvh, ci.dst, 32, ci.dr0, ci.k0 + 32 * (cvidx & 1), lane); }
    DMA_KP(j + 2 < NT ? j + 2 : NT - 1, 1); DMA_V(j + 1, 0);
    SBAR(); qkt(pA0, pA1, K_lds, P_lds, qr, qp, r32, hi);
    finishSM(pB0, pB1, alB, l_reg, pa0, pa1, pa2, pa3); SBAR();
    pv_d0(o, vb0 + (int)SHM_V, pa0, pa1, pa2, pa3); partialSM(pA0, pA1, m_reg, mnA, alA);
    RESC(alA); DWAIT(); __syncthreads();
  }
  DMA_V(NT - 1, 1);
  SBAR(); qkt(pB0, pB1, K_lds + SHM_K, P_lds + SHM_P, qr, qp, r32, hi);
  finishSM(pA0, pA1, alA, l_reg, pa0, pa1, pa2, pa3); SBAR();
  pv_d0(o, vb0, pa0, pa1, pa2, pa3); partialSM(pB0, pB1, m_reg, mnB, alB);
  RESC(alB); DWAIT(); __syncthreads();
  finishSM(pB0, pB1, alB, l_reg, pa0, pa1, pa2, pa3); SBAR();
  pv_d0(o, vb0 + (int)SHM_V, pa0, pa1, pa2, pa3);
  if (hi == 0) li_l[r32] = l_reg; asm volatile("s_waitcnt lgkmcnt(0)" ::: "memory");
  float rli[16];
#pragma unroll
  for (int r = 0; r < 16; ++r) rli[r] = __builtin_amdgcn_rcpf(li_l[crow(r, hi)]);
  bf16* Ow = Ob + (long)(wid * QBLK) * LDO;
#pragma unroll
  for (int r = 0; r < 16; ++r) { int orow = crow(r, hi);
#pragma unroll
    for (int d0 = 0; d0 < 4; ++d0) Ow[(long)orow * LDO + d0 * 32 + r32] = (bf16)f2bf(o[d0][r] * rli[r]); }
  __syncthreads();
#undef DMA_KP
#undef DMA_V
#undef DWAIT
#undef RESC
}
#undef KSWZ
#undef PSWZ
#undef SBAR
}
#ifndef DBG_SKIP
#define DBG_SKIP 0
#endif
__global__ void __launch_bounds__(NWAVES * 64, 2) fwd_kernel(Args args) {
    const Args& A = args;
    extern __shared__ __attribute__((aligned(16))) unsigned char lds[];
    Frame F;
    F.lds = (LAS unsigned char*)lds;
    F.MISC = (volatile LAS unsigned*)(F.lds + MISC_OFF);
    F.tid = threadIdx.x; F.lane = F.tid & 63; F.wave = __builtin_amdgcn_readfirstlane(F.tid >> 6);
    F.G = gridDim.x; { const int bx = blockIdx.x; F.vcu = (F.G % 8 == 0) ? (bx % 8) * (F.G / 8) + bx / 8 : bx; }
    F.ws = args.ws; F.ctl = (gu32*)(args.ws + WS_CTL); F.out = args.out;
    for (int u = F.tid; u < (LDS_BYTES - LDSCTL_OFF) / 4; u += NWAVES * 64) ((LAS unsigned*)(F.lds + LDSCTL_OFF))[u] = 0u;
    __syncthreads();
    XcdBarrier bar = xcd_barrier_post((unsigned*)(F.ctl + CW_BAR), F.MISC + 8);
    const int lo = args.ph_lo, hi = args.ph_hi;
#ifndef PH_MASK
#define PH_MASK 0xffffffffu
#endif
#define IN(k) ((((PH_MASK) >> (k)) & 1u) && lo <= (k) && (k) < hi)
#define SEAM(k) do { if (IN(k) && IN((k) + 1)) xcd_barrier(bar); } while (0)
#ifndef DUP_MASK
#define DUP_MASK 0u
#endif
#define REP(k) for (int rep_ = 0; rep_ < ((((DUP_MASK) >> (k)) & 1u) ? 2 : 1); ++rep_)
    const int bx = (int)blockIdx.x;

    if (IN(0)) REP(0) { p0_prologue(F, A); } SEAM(0);
    if (IN(1)) REP(1) { ph_mod0(F, A); } SEAM(1);
    if (IN(2)) REP(2) {
        pg8::Gemm g{WSP(bf16, WS_H), WSP(bf16, WS_WIN0), 2048, 2048, 2048}; pg8::DenseOrder S; S.init(R0 / 256, PW / 256 + 1, F.G, bx);
        pg8::EpiG1 E{WSP(bf16, WS_PB), PW, WSP(float, WS_GATES), A.in[11]};
        pg8::gemm_phase<pg8::EpiG1, pg8::DenseOrder>(F.lds, g, S, E);
    } SEAM(2);
    if (IN(3)) REP(3) { ph_conv_pool(F, A); } SEAM(3);
    if (IN(4)) REP(4) {
#ifndef NO_MLSTM
        for (int tk = F.vcu; tk < 256; tk += F.G) ml::mlstm_task(F, A, tk);
#endif
        pg8::Gemm g{WSP(bf16, WS_PU), WSP(bf16, WS_WPOOL), 1024, 256, 256}; pg8::PoolOrder S; S.init(R0 / 256, F.G, F.vcu);
        pg8::EpiBf16 E{WSP(bf16, WS_A2), 2048, 1024, 256, A.in[14] - 1024, nullptr};
#ifndef NO_POOLG
        pg8::gemm_phase<pg8::EpiBf16, pg8::PoolOrder>(F.lds, g, S, E);
#endif
    } SEAM(4);
    if (IN(5)) REP(5) { ph_readout(F, A); } SEAM(5);
    if (IN(6)) REP(6) {
        pg8::Gemm g{WSP(bf16, WS_A2), WSP(bf16, WS_WOUT0), 2048, 2048, 2048}; pg8::SplitOrder S; S.init(64, R0 / 256 - 64, 8, F.G, bx);
        pg8::EpiSig<pg8::EpiBf16> E{{WSP(bf16, WS_Y), 2048, 0, 0, nullptr, nullptr}, (unsigned*)(F.ctl + CW_RDY), (LAS unsigned*)(F.lds + MISC_OFF + 64)};
        pg8::gemm_phase<pg8::EpiSig<pg8::EpiBf16>, pg8::SplitOrder>(F.lds, g, S, E);
    }
    if (IN(7)) REP(7) {
        unsigned* rdy = (unsigned*)(F.ctl + CW_RDY);
        int first = F.vcu * NWAVES + F.wave, step = F.G * NWAVES, rend = R0, blo = 0, bhi = R0 / 256 - 1;
        if (F.G == 256) { if (bx >= 32) { first = (bx - 32) * NWAVES + F.wave; step = 224 * NWAVES; rend = 224 * 72; bhi = 62; } else { first = 224 * 72 + bx * NWAVES + F.wave; step = 32 * NWAVES; blo = 63; } }
        ph_post1(F, A, 0, first, step, rend, rdy, 8u, blo, bhi);
    } SEAM(7);
    if (IN(8)) REP(8) { for (int p = F.vcu; p < 128; p += F.G) topk_problem(F, A, p, SLOTS0); } SEAM(8);
    if (IN(9)) REP(9) {
        pg8::Gemm g{WSP(bf16, WS_H), WSP(bf16, WS_WM13), 2048, 2048, 2048}; pg8::MoeOrder<true> S; S.init(SLOTS0 / 256, 16, 4096, WSP(int, WS_RIDX), F.G, bx);
        pg8::EpiSwiGLU E{WSP(bf16, WS_ACT), 2048};
        pg8::gemm_phase<pg8::EpiSwiGLU, pg8::MoeOrder<true>>(F.lds, g, S, E);
    } SEAM(9);
    if (IN(10)) REP(10) {
        pg8::Gemm g{WSP(bf16, WS_ACT), WSP(bf16, WS_WM2), 2048, 2048, 2048}; pg8::MoeOrder<false> S; S.init(SLOTS0 / 256, 8, 2048, nullptr, F.G, bx);
        pg8::EpiBf16 E{WSP(bf16, WS_YS), 2048, 0, 0, nullptr, nullptr};
        pg8::gemm_phase<pg8::EpiBf16, pg8::MoeOrder<false>>(F.lds, g, S, E);
    } SEAM(10);
    if (IN(11)) REP(11) { ph_combine(F, A, 0, R0, SLOTS0); } SEAM(11);
    if (IN(12)) REP(12) {
        pg8::Gemm g{WSP(bf16, WS_H), WSP(bf16, WS_WMIN), 2048, 2048, 2048}; pg8::MlaInOrder S; S.init(F.G, bx);
        pg8::EpiBf16 E{WSP(bf16, WS_PL), PLW, 0, 0, nullptr, nullptr};
        pg8::gemm_phase<pg8::EpiBf16, pg8::MlaInOrder>(F.lds, g, S, E);
    } SEAM(12);
    if (IN(13)) REP(13) { ph_mla_norm(F, A); } SEAM(13);
    if (IN(14)) REP(14) {
        { pg8::Gemm g{WSP(bf16, WS_QN), WSP(bf16, WS_WUQ), 1536, 1536, 1536}; pg8::DenseOrder S; S.init(NL / 256, 12, F.G, bx);
          pg8::EpiRopeQ E{WSP(bf16, WS_QF), 3072, WSP(float, WS_ROPE)};
          pg8::gemm_phase<pg8::EpiRopeQ, pg8::DenseOrder>(F.lds, g, S, E); }
        { pg8::Gemm g{WSP(bf16, WS_KVN), WSP(bf16, WS_WUKV), 512, 512, 512}; pg8::DenseOrder S; S.init(R0 / 256, 16, F.G, bx);
          pg8::EpiBf16 E{WSP(bf16, WS_KV), 4096, 0, 0, nullptr, nullptr};
          pg8::gemm_phase<pg8::EpiBf16, pg8::DenseOrder>(F.lds, g, S, E); }
    } SEAM(14);
    if (IN(16)) REP(16) {
        if (F.G != 256) { const int gw_ = F.vcu * NWAVES + F.wave; for (int q = gw_; q < MOE_L1_ITEMS; q += F.G * NWAVES) { const MoeItem ci = moe_item(F, A, moe_l1_m(q)); transpose_item(ci.src, 2048, ci.k0, ci.n0, ci.dst, 32, ci.dr0, nullptr, F.lane); } }
        int useq = 0;
        for (int id = F.vcu; id < NB * AH * 16; id += F.G, ++useq) {
            const int bh = id >> 4, qb = id & 15, b = bh >> 4, h = bh & 15;
            const bf16* Qb = WSP(bf16, WS_QF) + (size_t)(b * SEQ + qb * 256) * 3072 + h * 192;
            const bf16* Kh = WSP(bf16, WS_KV) + (size_t)(b * KVS) * 4096 + h * 256;
            const bf16* Kp = WSP(bf16, WS_KPE) + (size_t)(b * KVS) * 64;
            bf16* Ob = WSP(bf16, WS_O) + (size_t)(b * SEQ + qb * 256) * 2048 + h * 128;
            at::attn_unit(Qb, Kh, Kh + 128, Kp, Ob, KVS, (char*)lds, F, A, F.G == 256 ? useq * CVA_PER_UNIT * 2048 + F.vcu * NWAVES + F.wave : -1);
        }
    } SEAM(16);
    if (IN(17)) REP(17) {
        pg8::Gemm g{WSP(bf16, WS_O), WSP(bf16, WS_WO), 2048, 2048, 2048}; pg8::DenseOrder S; S.init(NL / 256, 8, F.G, bx);
        pg8::EpiBf16 E{WSP(bf16, WS_Y), 2048, 0, 0, nullptr, nullptr};
        pg8::gemm_phase<pg8::EpiBf16, pg8::DenseOrder>(F.lds, g, S, E);
    } SEAM(17);
    if (IN(18)) REP(18) { ph_post1(F, A, 1, F.vcu * NWAVES + F.wave, F.G * NWAVES, NL, nullptr, 0u, 0, -1); } SEAM(18);
    if (IN(19)) REP(19) { for (int p = F.vcu; p < 64; p += F.G) topk_problem(F, A, p, SLOTS1); } SEAM(19);
    if (IN(20)) REP(20) {
        pg8::Gemm g{WSP(bf16, WS_H), WSP(bf16, WS_WM13) + (size_t)16 * 4096 * 2048, 2048, 2048, 2048}; pg8::MoeOrder<true> S; S.init(SLOTS1 / 256, 16, 4096, WSP(int, WS_RIDX), F.G, bx);
        pg8::EpiSwiGLU E{WSP(bf16, WS_ACT), 2048};
        pg8::gemm_phase<pg8::EpiSwiGLU, pg8::MoeOrder<true>>(F.lds, g, S, E);
    } SEAM(20);
    if (IN(21)) REP(21) {
        pg8::Gemm g{WSP(bf16, WS_ACT), WSP(bf16, WS_WM2) + (size_t)16 * 2048 * 2048, 2048, 2048, 2048}; pg8::MoeOrder<false> S; S.init(SLOTS1 / 256, 8, 2048, nullptr, F.G, bx);
        pg8::EpiBf16 E{WSP(bf16, WS_YS), 2048, 0, 0, nullptr, nullptr};
        pg8::gemm_phase<pg8::EpiBf16, pg8::MoeOrder<false>>(F.lds, g, S, E);
    } SEAM(21);
    if (IN(22)) REP(22) {
        ph_combine(F, A, 1, NL, SLOTS1);
        if (xb_ld((unsigned*)(F.ctl + CW_BAR) + XB_TMO) != 0u) {
            const int gw = F.vcu * NWAVES + F.wave, NGW = F.G * NWAVES; const float qn = __builtin_nanf("");
            for (int r = gw; r < NL; r += NGW) F.out[(size_t)r * DM + F.lane] = qn;
        }
    }
#undef IN
#undef SEAM
}
constexpr int N_PHASES = 23;

#ifndef MK_PER_PHASE
#define MK_PER_PHASE 0
#endif
extern "C" void kernel_launch(void* const* d_in, const int* in_sizes, int n_in, void* d_out, int out_size, void* d_ws, size_t ws_size, hipStream_t stream) {
    static int grid = 0;
    if (grid == 0) {
        if (n_in != 26 || in_sizes[0] != NL * DM || out_size != NL * DM || ws_size < WS_END) {
            fprintf(stderr, "kernel_launch: shape mismatch: n_in %d in0 %d out %d ws %zu (need %zu); nothing launched\n", n_in, n_in > 0 ? in_sizes[0] : -1, out_size, ws_size, (size_t)WS_END); grid = -1; return; }
        int dev = 0, cus = 0, per_cu = 0;
        if (hipGetDevice(&dev) != hipSuccess || hipDeviceGetAttribute(&cus, hipDeviceAttributeMultiprocessorCount, dev) != hipSuccess) { grid = -1; return; }
        if (hipFuncSetAttribute((const void*)fwd_kernel, hipFuncAttributeMaxDynamicSharedMemorySize, LDS_BYTES) != hipSuccess) { fprintf(stderr, "kernel_launch: hipFuncSetAttribute failed\n"); grid = -1; return; }
        if (hipOccupancyMaxActiveBlocksPerMultiprocessor(&per_cu, (const void*)fwd_kernel, NWAVES * 64, LDS_BYTES) != hipSuccess || per_cu < 1)
            fprintf(stderr, "kernel_launch: note: occupancy query reports %d workgroups per CU\n", per_cu);
        (void)hipGetLastError();
        grid = cus;
    }
    if (grid < 0) return;
    if (hipMemsetAsync((char*)d_ws + WS_CTL, 0, CTL_ZERO_BYTES, stream) != hipSuccess) { fprintf(stderr, "kernel_launch: memset failed\n"); return; }
    Args a{};
    for (int i = 0; i < 26; ++i) a.in[i] = (const float*)d_in[i];
    a.out = (float*)d_out; a.ws = (unsigned char*)d_ws;
#if MK_PER_PHASE
    for (int p = 0; p < N_PHASES; ++p) { a.ph_lo = p; a.ph_hi = p + 1; hipLaunchKernelGGL(fwd_kernel, dim3(grid), dim3(NWAVES * 64), LDS_BYTES, stream, a); }
#else
    a.ph_lo = 0; a.ph_hi = N_PHASES;
    hipLaunchKernelGGL(fwd_kernel, dim3(grid), dim3(NWAVES * 64), LDS_BYTES, stream, a);
#endif
    const hipError_t le = hipPeekAtLastError();
    if (le != hipSuccess) fprintf(stderr, "kernel_launch: launch failed: %s\n", hipGetErrorName(le));
}
```

```cpp
#include <hip/hip_runtime.h>
#include <cstdio>
#include <cstdint>

#define GAS __attribute__((address_space(1)))
#define LAS __attribute__((address_space(3)))
typedef unsigned short bf16;
typedef unsigned v4u __attribute__((ext_vector_type(4)));
typedef unsigned v2u __attribute__((ext_vector_type(2)));
typedef float f32x4 __attribute__((ext_vector_type(4)));
typedef float f32x2 __attribute__((ext_vector_type(2)));
typedef float f32x16 __attribute__((ext_vector_type(16)));
typedef short bf16x8 __attribute__((ext_vector_type(8)));
typedef short s16x4 __attribute__((ext_vector_type(4)));
typedef GAS unsigned gu32;
#define RLX_AGENT __ATOMIC_RELAXED, __HIP_MEMORY_SCOPE_AGENT
#define LDS_WAIT() asm volatile("s_waitcnt lgkmcnt(0)" ::: "memory")
#define VM_WAIT() asm volatile("s_waitcnt vmcnt(0)" ::: "memory")

constexpr int DM = 2048, NB = 4, SEQ = 4096, CTXL = 256;
constexpr int NL = NB * SEQ;
constexpr int NCX = NB * CTXL;
constexpr int R0 = NL + NCX;
constexpr int MH = 4, MDIM = 1024, MHD = 256, INAB = 5136, PW = 5120;
constexpr int QLORA = 1536, KVLORA = 512, ROPE = 64, NOPE = 128, VD = 128, AH = 16, INC = 2112, PLW = 2304;
constexpr int NE = 16, CAPL = 512, CAPC = 32;
constexpr int SLOTS0 = 2304, SLOTS1 = 2048;
constexpr int KVS = CTXL + SEQ;
constexpr float LN_EPS = 1e-5f, RMS_EPS = 1e-6f;
constexpr float ALPHA = 1.4142135623730951f;

constexpr size_t MiB = 1u << 20;
constexpr size_t WS_CTL = 0, CTL_ZERO_BYTES = 1 * MiB;
constexpr size_t WS_MOD = 1 * MiB;
constexpr size_t WS_AFF = 3 * MiB;
constexpr size_t WS_RIDX = 5 * MiB;
constexpr size_t WS_RGATE = 5 * MiB + 256 * 1024;
constexpr size_t WS_RSLOT = 6 * MiB;
constexpr size_t WS_GATES = 8 * MiB;
constexpr size_t WS_KPE = 10 * MiB;
constexpr size_t WS_ROPE = 13 * MiB;
constexpr size_t WS_WIN0 = 1660 * MiB;
constexpr size_t WS_WOUT0 = 36 * MiB;
constexpr size_t WS_WPOOL = 44 * MiB;
constexpr size_t WS_WMIN = 45 * MiB;
constexpr size_t WS_WUQ = 54 * MiB;
constexpr size_t WS_WUKV = 63 * MiB;
constexpr size_t WS_WO = 67 * MiB;
constexpr size_t WS_WM13 = 76 * MiB;
constexpr size_t WS_WM2 = 588 * MiB;
constexpr size_t WS_X1 = 844 * MiB;
constexpr size_t WS_H = 980 * MiB;
constexpr size_t WS_Y = 1048 * MiB;
constexpr size_t WS_MIX = 1184 * MiB;
constexpr size_t WS_PB = WS_MIX;
constexpr size_t WS_QK = WS_MIX + 170 * MiB;
constexpr size_t WS_PU = WS_MIX + 238 * MiB;
constexpr size_t WS_HF = WS_MIX + 272 * MiB;
constexpr size_t WS_A2 = WS_MIX + 408 * MiB;
constexpr size_t WS_PL = WS_MIX;
constexpr size_t WS_QN = WS_MIX + 77 * MiB;
constexpr size_t WS_KVN = WS_MIX + 125 * MiB;
constexpr size_t WS_QF = WS_MIX + 142 * MiB;
constexpr size_t WS_KV = WS_MIX + 238 * MiB;
constexpr size_t WS_O = WS_MIX + 374 * MiB;
constexpr size_t WS_ACT = WS_MIX;
constexpr size_t WS_YS = WS_MIX + 144 * MiB;
constexpr size_t WS_END = WS_MIX + 476 * MiB + 21 * MiB;
static_assert(WS_QK + (size_t)R0 * 2048 * 2 <= WS_PU && WS_PU + (size_t)R0 * 1024 * 2 <= WS_HF && WS_HF + (size_t)2 * R0 * 1024 * 4 <= WS_A2 && WS_A2 + (size_t)R0 * 2048 * 2 <= WS_END, "mix map 0");
static_assert(WS_PL + (size_t)R0 * PLW * 2 <= WS_QN && WS_QN + (size_t)NL * 1536 * 2 <= WS_KVN && WS_KVN + (size_t)R0 * 512 * 2 <= WS_QF && WS_QF + (size_t)NL * 3072 * 2 <= WS_KV && WS_KV + (size_t)R0 * 4096 * 2 <= WS_O && WS_O + (size_t)NL * 2048 * 2 <= WS_END, "mix map 1");
static_assert(WS_ACT + (size_t)16 * 2304 * 2048 * 2 <= WS_YS && WS_YS + (size_t)16 * 2304 * 2048 * 2 <= WS_END, "mix map moe");
static_assert(WS_PB + (size_t)R0 * PW * 2 <= WS_QK, "pb");

constexpr int CW_TMO = 0, CW_CODE = 1, CW_BAR = 4096;
constexpr int CW_RDY = 16384;

constexpr int LDS_BYTES = 151552;
constexpr int LDSCTL_OFF = 147456, MISC_OFF = LDSCTL_OFF + 320;
constexpr int NWAVES = 8;

__device__ __forceinline__ unsigned f2bf(float f) { unsigned u = __builtin_bit_cast(unsigned, f); return (u + 0x7fffu + ((u >> 16) & 1u)) >> 16; }
__device__ __forceinline__ unsigned pk2(float lo, float hi) { unsigned r; asm("v_cvt_pk_bf16_f32 %0, %1, %2" : "=v"(r) : "v"(lo), "v"(hi)); return r; }
__device__ __forceinline__ float bf2f(unsigned short b) { return __builtin_bit_cast(float, (unsigned)b << 16); }
__device__ __forceinline__ float bflo(unsigned w) { return __builtin_bit_cast(float, w << 16); }
__device__ __forceinline__ float bfhi(unsigned w) { return __builtin_bit_cast(float, w & 0xffff0000u); }
template <int CTRL> __device__ __forceinline__ float dpp_mov(float v) { return __uint_as_float((unsigned)__builtin_amdgcn_update_dpp(0, (int)__float_as_uint(v), CTRL, 0xF, 0xF, true)); }
__device__ __forceinline__ float wave_sum(float v) {
    v += dpp_mov<0xB1>(v);
    v += dpp_mov<0x4E>(v);
    v += dpp_mov<0x141>(v);
    v += dpp_mov<0x140>(v);
    { auto rr = __builtin_amdgcn_permlane16_swap(__float_as_uint(v), __float_as_uint(v), false, false); v = __uint_as_float(rr[0]) + __uint_as_float(rr[1]); }
    { auto rr = __builtin_amdgcn_permlane32_swap(__float_as_uint(v), __float_as_uint(v), false, false); v = __uint_as_float(rr[0]) + __uint_as_float(rr[1]); }
    return v;
}
__device__ __forceinline__ float siluf(float x) { return x / (1.f + __expf(-x)); }
__device__ __forceinline__ float sigmoidf_(float x) { return 1.f / (1.f + __expf(-x)); }

#define XB_TMO      128
#define XB_XCNT(j)  (256  + 64 * (j))
#define XB_XSUB(j)  (1280 + 64 * (j))
#define XB_XGEN(j)  (2304 + 64 * (j))
#define XB_TOP      3328
#define XB_TOPGEN   3392
#define XCD_BAR_WORDS 3456
#define XB_SPIN_CAP (1u << 18)
__device__ __forceinline__ unsigned xb_ld(unsigned* p)              { return __hip_atomic_load(p, __ATOMIC_RELAXED, __HIP_MEMORY_SCOPE_AGENT); }
__device__ __forceinline__ unsigned xb_add(unsigned* p, unsigned v) { return __hip_atomic_fetch_add(p, v, __ATOMIC_RELAXED, __HIP_MEMORY_SCOPE_AGENT); }
__device__ __forceinline__ unsigned xb_xcc_id() { return (unsigned)__builtin_amdgcn_s_getreg((3 << 11) | 20) & 0xFu; }
#define XB_SPIN(cond, bar) do { unsigned _sp = 0; while (cond) { __builtin_amdgcn_s_sleep(1); \
    if ((++_sp & 255u) == 0u) { if (xb_ld(&(bar)[XB_TMO])) break; if (_sp > XB_SPIN_CAP) { atomicAdd(&(bar)[XB_TMO], 1u); break; } } } } while (0)
struct XcdBarrier { unsigned* bar; unsigned x; volatile LAS unsigned* st; };
__device__ __forceinline__ XcdBarrier xcd_barrier_post(unsigned* bar, volatile LAS unsigned* st) {
    XcdBarrier b; b.bar = bar; b.x = xb_xcc_id(); b.st = st;
    if (threadIdx.x == 0) (void)xb_add(&bar[XB_XCNT(b.x)], 1u);
    return b;
}
__device__ __forceinline__ void xcd_barrier_complete(unsigned* bar, unsigned x, unsigned& nloc, unsigned& nx) {
    const unsigned G = gridDim.x * gridDim.y * gridDim.z;
    unsigned sum, cnt, mine, sp = 0u;
    for (;;) {
        sum = 0u; cnt = 0u; mine = 0u;
#pragma unroll
        for (unsigned j = 0; j < 16; ++j) { const unsigned c = xb_ld(&bar[XB_XCNT(j)]); sum += c; cnt += (c > 0u) ? 1u : 0u; mine = (j == x) ? c : mine; }
        if (sum == G) break;
        __builtin_amdgcn_s_sleep(1);
        if ((++sp & 255u) == 0u) { if (xb_ld(&bar[XB_TMO])) break; if (sp > XB_SPIN_CAP) { atomicAdd(&bar[XB_TMO], 1u); break; } }
    }
    nloc = mine > 0u ? mine : 1u; nx = cnt > 0u ? cnt : 1u;
}
__device__ __forceinline__ void xcd_barrier(const XcdBarrier& b) {
    asm volatile("s_waitcnt vmcnt(0)" ::: "memory");
    __syncthreads();
    if (threadIdx.x == 0) {
        unsigned* bar = b.bar;
        __builtin_amdgcn_s_waitcnt(0);
        unsigned nloc = b.st[0], nx = b.st[1];
        if (nloc == 0u) { xcd_barrier_complete(bar, b.x, nloc, nx); b.st[0] = nloc; b.st[1] = nx; }
        const unsigned old = xb_add(&bar[XB_XSUB(b.x)], 1u);
        const unsigned gen = old / nloc;
        if (old + 1u == (gen + 1u) * nloc) {
            __builtin_amdgcn_fence(__ATOMIC_RELEASE, "agent");
            asm volatile("s_waitcnt vmcnt(0)" ::: "memory");
            const unsigned og = xb_add(&bar[XB_TOP], 1u);
            const unsigned tg = og / nx;
            if (og + 1u == (tg + 1u) * nx) xb_add(&bar[XB_TOPGEN], 1u);
            else XB_SPIN(xb_ld(&bar[XB_TOPGEN]) == tg, bar);
            __builtin_amdgcn_fence(__ATOMIC_ACQUIRE, "agent");
            xb_add(&bar[XB_XGEN(b.x)], 1u);
            asm volatile("s_waitcnt vmcnt(0)" ::: "memory");
        } else {
            XB_SPIN(xb_ld(&bar[XB_XGEN(b.x)]) == gen, bar);
            __builtin_amdgcn_fence(__ATOMIC_ACQUIRE, "agent");
            asm volatile("s_waitcnt vmcnt(0)" ::: "memory");
        }
    }
    __syncthreads();
}

namespace pg8 {
#define PG8_LAS __attribute__((address_space(3)))
typedef unsigned short bf16_t;
typedef unsigned u32x4 __attribute__((ext_vector_type(4)));
constexpr int BM = 256, BK = 64, HALF = 128, HTB = HALF * BK * 2, STAGE_BYTES = 8 * HTB, NXCD = 8, WGM = 8;
__host__ __device__ __forceinline__ int lds_byte(int r, int c) { const int st = (r >> 4) * 2 + (c >> 5), rr = r & 15, cc = c & 31, ob = rr * 64 + cc * 2; return st * 1024 + (ob ^ (((ob >> 9) & 1) << 5)); }
__host__ __device__ __forceinline__ void stage_rc(int b, int& R, int& C) { const int st = b / 1024, sb = b % 1024, swz = sb ^ (((sb >> 9) & 1) << 5); R = (st >> 1) * 16 + swz / 64; C = (st & 1) * 32 + (swz % 64) / 2; }
__host__ __device__ __forceinline__ int perm32(int rho) { const int n = rho >> 4, i = rho & 15; return 8 * (i >> 2) + 4 * n + (i & 3); }

struct Unit { int pm, pn, g, skiphi; };
struct Gemm { const bf16_t* A; const bf16_t* Bt; int lda, ldb, K; };
__device__ __forceinline__ unsigned cvt_pk_bf16(float lo, float hi) { unsigned r; asm volatile("v_cvt_pk_bf16_f32 %0, %1, %2" : "=v"(r) : "v"(lo), "v"(hi)); return r; }

__device__ __forceinline__ int xcd_remap(int L, int nwg) { const int q = nwg / NXCD, r = nwg % NXCD, xcd = L % NXCD, off = L / NXCD; return (xcd < r ? xcd * (q + 1) : r * (q + 1) + (xcd - r) * q) + off; }

struct DenseOrder {
    int nM, nN, nwg, G, c, pm0;
    __device__ void init(int nM_, int nN_, int G_, int c_, int pm0_ = 0) { nM = nM_; nN = nN_; nwg = nM * nN; G = G_; c = c_; pm0 = pm0_; }
    __device__ void at(int L, Unit& u) const {
        const int wgid = xcd_remap(L, nwg);
        const int nig = WGM * nN, gid = wgid / nig, fm = gid * WGM, gsz = (nM - fm) < WGM ? (nM - fm) : WGM;
        u.pm = pm0 + fm + ((wgid % nig) % gsz); u.pn = (wgid % nig) / gsz; u.g = 0; u.skiphi = 0;
    }
    __device__ bool next(int i, Unit& u) const { const long L = (long)i * G + c; if (L >= nwg) return false; at((int)L, u); return true; }
    __device__ __forceinline__ unsigned arow(const Unit& u, int r) const { return (unsigned)(u.pm * BM + r); }
    __device__ __forceinline__ unsigned acol2(const Unit&) const { return 0u; }
    __device__ __forceinline__ size_t boff(const Unit& u, int ldb) const { return (size_t)u.pn * BM * ldb; }
};
struct SplitOrder {
    DenseOrder m, t;
    __device__ void init(int nM1, int nM2, int nN, int G, int c) { m.init(nM1, nN, G, c, 0); t.init(nM2, nN, G, c, nM1); }
    __device__ bool next(int i, Unit& u) const { long L = (long)i * m.G + m.c; if (L < m.nwg) { m.at((int)L, u); return true; } L -= m.nwg; if (L >= t.nwg) return false; t.at((int)L, u); return true; }
    __device__ __forceinline__ unsigned arow(const Unit& u, int r) const { return (unsigned)(u.pm * BM + r); }
    __device__ __forceinline__ unsigned acol2(const Unit&) const { return 0u; }
    __device__ __forceinline__ size_t boff(const Unit& u, int ldb) const { return (size_t)u.pn * BM * ldb; }
};

template <class Epi, class Sched, bool ALIGN_EPI = true>
__device__ __forceinline__ void gemm_phase(PG8_LAS unsigned char* lds, const Gemm g, const Sched& S, const Epi& E) {
    int tid = threadIdx.x; asm volatile("" : "+v"(tid));
    const int wid = __builtin_amdgcn_readfirstlane(tid >> 6), lane = tid & 63, wr = wid >> 2, wc = wid & 3, fr = lane & 15, fq = lane >> 4;
    const int K = g.K, nt = K / BK;
    int RA[2]; unsigned CA2[2], voffB[2];
#pragma unroll
    for (int i = 0; i < 2; ++i) { int R, C; stage_rc(tid * 16 + i * 8192, R, C); const int Rb = Epi::PERM ? ((R & ~31) + perm32(R & 31)) : R;
        RA[i] = R; CA2[i] = (unsigned)C * 2u; voffB[i] = (unsigned)(Rb * BK + C) * 2u; }
    const unsigned lda2 = (unsigned)g.lda * 2u;
    const size_t kstep = (size_t)(BK * 2);
    const size_t hstepB = (size_t)HALF * BK * 2, kstepB = (size_t)BM * BK * 2;
    const unsigned ldsw = (unsigned)wid * 1024u;
    const int aoff = lds_byte(wr * 64 + fr, fq * 8), boff = lds_byte(wc * 32 + fr, fq * 8);
#define PG8_SA(b, h) (((b) * 2 + (h)) * HTB)
#define PG8_SB(b, h) ((4 + (b) * 2 + (h)) * HTB)
#define PG8_STAGEB(bufoff, gbase) do { _Pragma("unroll") for (int _i = 0; _i < 2; ++_i) \
        __builtin_amdgcn_global_load_lds((const unsigned*)((const char*)(gbase) + voffB[_i]), (PG8_LAS unsigned*)(lds + (bufoff) + ldsw + _i * 8192), 16, 0, 0); } while (0)
#define PG8_STAGEA(bufoff, kb, off) do { _Pragma("unroll") for (int _i = 0; _i < 2; ++_i) \
        __builtin_amdgcn_global_load_lds((const unsigned*)(Ab + (kb) + (off)[_i]), (PG8_LAS unsigned*)(lds + (bufoff) + ldsw + _i * 8192), 16, 0, 0); } while (0)
#define PG8_LDA(dst, b, h) do { _Pragma("unroll") for (int m = 0; m < 4; ++m) _Pragma("unroll") for (int k = 0; k < 2; ++k) dst[m][k] = *(const PG8_LAS bf16x8*)(lds + PG8_SA(b, h) + aoff + m * 2048 + k * 1024); } while (0)
#define PG8_LDB(dst, b, h) do { _Pragma("unroll") for (int n = 0; n < 2; ++n) _Pragma("unroll") for (int k = 0; k < 2; ++k) dst[n][k] = *(const PG8_LAS bf16x8*)(lds + PG8_SB(b, h) + boff + n * 2048 + k * 1024); } while (0)
#define PG8_MMA(ai, bj, At, Bt) do { __builtin_amdgcn_s_setprio(1); _Pragma("unroll") for (int m = 0; m < 4; ++m) _Pragma("unroll") for (int n = 0; n < 2; ++n) _Pragma("unroll") for (int k = 0; k < 2; ++k) \
        acc[ai][bj][m][n] = __builtin_amdgcn_mfma_f32_16x16x32_bf16(Bt[n][k], At[m][k], acc[ai][bj][m][n], 0, 0, 0); __builtin_amdgcn_s_setprio(0); } while (0)
#define PG8_WAIT_V(n) asm volatile("s_waitcnt vmcnt(" #n ")" ::: "memory")
#define PG8_WAIT_L(n) asm volatile("s_waitcnt lgkmcnt(" #n ")" ::: "memory")
#define PG8_BAR __builtin_amdgcn_s_barrier()
#define PG8_SCHED __builtin_amdgcn_sched_barrier(0)
#define PG8_AOFF(dst, u) do { _Pragma("unroll") for (int _h = 0; _h < 2; ++_h) _Pragma("unroll") for (int _i = 0; _i < 2; ++_i) dst[_h][_i] = S.arow(u, _h * HALF + RA[_i]) * lda2 + CA2[_i] + S.acol2(u); } while (0)
    Unit cur, nxt; int ui = 0;
    if (!S.next(0, cur)) return;
    f32x4 acc[2][2][4][2];
#pragma unroll
    for (int a = 0; a < 2; ++a)
#pragma unroll
        for (int b = 0; b < 2; ++b)
#pragma unroll
            for (int m = 0; m < 4; ++m)
#pragma unroll
                for (int n = 0; n < 2; ++n) acc[a][b][m][n] = (f32x4){0.f, 0.f, 0.f, 0.f};
    bf16x8 At[4][2], B0[2][2], B1[2][2];
    unsigned oAc[2][2], oAn[2][2];
    PG8_AOFF(oAc, cur);
    const char* Ab = (const char*)g.A;
    const char* cB = (const char*)g.Bt + S.boff(cur, g.ldb) * 2;
    PG8_STAGEB(PG8_SB(0, 0), cB); PG8_STAGEB(PG8_SB(0, 1), cB + hstepB); PG8_STAGEA(PG8_SA(0, 0), (size_t)0, oAc[0]); PG8_STAGEA(PG8_SA(0, 1), (size_t)0, oAc[1]);
    if (wr == 1) PG8_BAR;
    PG8_WAIT_V(2); PG8_BAR;
    PG8_STAGEB(PG8_SB(1, 0), cB + kstepB); PG8_STAGEA(PG8_SA(1, 0), kstep, oAc[0]); PG8_STAGEB(PG8_SB(1, 1), cB + hstepB + kstepB);
    PG8_WAIT_V(6); PG8_BAR;
    for (;;) {
        const bool has_next = S.next(ui + 1, nxt);
        const char* nB = cB;
        if (has_next) { PG8_AOFF(oAn, nxt); nB = (const char*)g.Bt + S.boff(nxt, g.ldb) * 2; }
        else {
#pragma unroll
            for (int h = 0; h < 2; ++h)
#pragma unroll
                for (int i = 0; i < 2; ++i) oAn[h][i] = oAc[h][i];
        }
        const bool skiphi = cur.skiphi != 0;
#pragma unroll 1
        for (int t = 0; t < nt; t += 2) {
            const bool last = (t == nt - 2);
            const size_t k1 = (size_t)(t + 1) * kstep;
            const size_t k2 = last ? (size_t)0 : (size_t)(t + 2) * kstep, k3 = k2 + kstep;
            const char* b2 = last ? nB : cB + (size_t)(t + 2) * kstepB; const char* b3 = b2 + kstepB;
            unsigned o2[2][2];
#pragma unroll
            for (int h = 0; h < 2; ++h)
#pragma unroll
                for (int i = 0; i < 2; ++i) o2[h][i] = last ? oAn[h][i] : oAc[h][i];
            PG8_LDB(B0, 0, 0); PG8_LDB(B1, 0, 1); PG8_SCHED; PG8_LDA(At, 0, 0); PG8_STAGEA(PG8_SA(1, 1), k1, oAc[1]);
            PG8_WAIT_V(8); PG8_WAIT_L(0); PG8_BAR; PG8_MMA(0, 0, At, B0); PG8_MMA(0, 1, At, B1); PG8_BAR; PG8_SCHED;
            PG8_LDA(At, 0, 1); PG8_STAGEB(PG8_SB(0, 0), b2); PG8_STAGEB(PG8_SB(0, 1), b2 + hstepB); PG8_STAGEA(PG8_SA(0, 0), k2, o2[0]);
            PG8_WAIT_V(8); PG8_WAIT_L(0); PG8_BAR; if (!skiphi) { PG8_MMA(1, 0, At, B0); PG8_MMA(1, 1, At, B1); } PG8_BAR; PG8_SCHED;
            PG8_LDB(B0, 1, 0); PG8_LDB(B1, 1, 1); PG8_SCHED; PG8_LDA(At, 1, 0); PG8_STAGEA(PG8_SA(0, 1), k2, o2[1]);
            PG8_WAIT_V(8); PG8_WAIT_L(0); PG8_BAR; PG8_MMA(0, 0, At, B0); PG8_MMA(0, 1, At, B1); PG8_BAR; PG8_SCHED;
            PG8_LDA(At, 1, 1); PG8_STAGEB(PG8_SB(1, 0), b3); PG8_STAGEB(PG8_SB(1, 1), b3 + hstepB); PG8_STAGEA(PG8_SA(1, 0), k3, o2[0]);
            PG8_WAIT_V(8); PG8_WAIT_L(0); PG8_BAR; if (!skiphi) { PG8_MMA(1, 0, At, B0); PG8_MMA(1, 1, At, B1); } PG8_BAR; PG8_SCHED;
        }
        if constexpr (ALIGN_EPI) { if (wr == 0) PG8_BAR; }
        E(acc, cur, wr, wc, fr, fq);
        if (!has_next) break;
#pragma unroll
        for (int a = 0; a < 2; ++a)
#pragma unroll
            for (int b = 0; b < 2; ++b)
#pragma unroll
                for (int m = 0; m < 4; ++m)
#pragma unroll
                    for (int n = 0; n < 2; ++n) acc[a][b][m][n] = (f32x4){0.f, 0.f, 0.f, 0.f};
        cur = nxt; cB = nB; ++ui;
#pragma unroll
        for (int h = 0; h < 2; ++h)
#pragma unroll
            for (int i = 0; i < 2; ++i) oAc[h][i] = oAn[h][i];
        if constexpr (ALIGN_EPI) { if (wr == 1) PG8_BAR; }
    }
    PG8_WAIT_V(0);
    if constexpr (!ALIGN_EPI) { if (wr == 0) PG8_BAR; }
    PG8_BAR;
#undef PG8_SA
#undef PG8_SB
#undef PG8_STAGEA
#undef PG8_STAGEB
#undef PG8_LDA
#undef PG8_LDB
#undef PG8_MMA
#undef PG8_WAIT_V
#undef PG8_WAIT_L
#undef PG8_BAR
#undef PG8_SCHED
#undef PG8_AOFF
}

struct EpiBf16 {
    static constexpr bool PERM = true;
    bf16_t* O; int ldc, coloff, gcol; const float* colscale; const float* rowscale;
    __device__ __forceinline__ void operator()(const f32x4 (&acc)[2][2][4][2], const Unit& u, int wr, int wc, int fr, int fq) const {
        const int row0 = u.pm * BM + wr * 64 + fr; const int col0 = coloff + u.g * gcol + u.pn * BM + wc * 32 + 8 * fq;
        f32x4 cs[2][2];
#pragma unroll
        for (int bj = 0; bj < 2; ++bj)
#pragma unroll
            for (int n = 0; n < 2; ++n) cs[bj][n] = colscale ? *(const f32x4*)(colscale + col0 + bj * HALF + 4 * n) : (f32x4){1.f, 1.f, 1.f, 1.f};
        float rsv[2][4];
#pragma unroll
        for (int ai = 0; ai < 2; ++ai)
#pragma unroll
            for (int m = 0; m < 4; ++m) rsv[ai][m] = rowscale ? *(const GAS float*)(rowscale + row0 + ai * HALF + m * 16) : 1.f;
#pragma unroll
        for (int ai = 0; ai < 2; ++ai)
#pragma unroll
            for (int m = 0; m < 4; ++m) { const int row = row0 + ai * HALF + m * 16; bf16_t* rowp = O + (size_t)row * ldc + col0;
                const float rs = rsv[ai][m];
#pragma unroll
                for (int bj = 0; bj < 2; ++bj) { const f32x4 v0 = acc[ai][bj][m][0] * cs[bj][0] * rs, v1 = acc[ai][bj][m][1] * cs[bj][1] * rs;
                    u32x4 w; w.x = cvt_pk_bf16(v0[0], v0[1]); w.y = cvt_pk_bf16(v0[2], v0[3]); w.z = cvt_pk_bf16(v1[0], v1[1]); w.w = cvt_pk_bf16(v1[2], v1[3]);
                    *(u32x4*)(rowp + bj * HALF) = w; } }
    }
};

template <class Inner> struct EpiSig {
    static constexpr bool PERM = Inner::PERM;
    Inner in; unsigned* rdy; PG8_LAS unsigned* lcnt;
    __device__ __forceinline__ void operator()(const f32x4 (&acc)[2][2][4][2], const Unit& u, int wr, int wc, int fr, int fq) const {
        in(acc, u, wr, wc, fr, fq);
        asm volatile("s_waitcnt vmcnt(0)" ::: "memory");
        if ((fr | fq) == 0) {
            const unsigned old = __hip_atomic_fetch_add(lcnt, 1u, __ATOMIC_RELAXED, __HIP_MEMORY_SCOPE_WORKGROUP);
            if ((old & 7u) == 7u) { __builtin_amdgcn_fence(__ATOMIC_RELEASE, "agent"); asm volatile("s_waitcnt vmcnt(0)" ::: "memory");
                (void)__hip_atomic_fetch_add(rdy + u.pm, 1u, __ATOMIC_RELAXED, __HIP_MEMORY_SCOPE_AGENT); }
        }
    }
};

struct EpiG1 {
    static constexpr bool PERM = true;
    bf16_t* O; int ldc; float* GT; const float* gate_b;
    __device__ __forceinline__ void operator()(const f32x4 (&acc)[2][2][4][2], const Unit& u, int wr, int wc, int fr, int fq) const {
        const int row0 = u.pm * BM + wr * 64 + fr;
        if (u.pn < 20) {
            const int col0 = u.pn * BM + wc * 32 + 8 * fq;
#pragma unroll
            for (int ai = 0; ai < 2; ++ai)
#pragma unroll
                for (int m = 0; m < 4; ++m) { bf16_t* rowp = O + (size_t)(row0 + ai * HALF + m * 16) * ldc + col0;
#pragma unroll
                    for (int bj = 0; bj < 2; ++bj) { const f32x4 v0 = acc[ai][bj][m][0], v1 = acc[ai][bj][m][1];
                        u32x4 w; w.x = cvt_pk_bf16(v0[0], v0[1]); w.y = cvt_pk_bf16(v0[2], v0[3]); w.z = cvt_pk_bf16(v1[0], v1[1]); w.w = cvt_pk_bf16(v1[2], v1[3]);
                        *(u32x4*)(rowp + bj * HALF) = w; } }
        } else if (wc == 0 && fq < 2) {
            const f32x4 b0 = *(const f32x4*)(gate_b + 8 * fq), b1 = *(const f32x4*)(gate_b + 8 * fq + 4);
#pragma unroll
            for (int ai = 0; ai < 2; ++ai)
#pragma unroll
                for (int m = 0; m < 4; ++m) { float* gp = GT + (size_t)(row0 + ai * HALF + m * 16) * 16 + 8 * fq;
                    *(f32x4*)gp = acc[ai][0][m][0] + b0; *(f32x4*)(gp + 4) = acc[ai][0][m][1] + b1; }
        }
    }
};
struct EpiRopeQ {
    static constexpr bool PERM = true;
    bf16_t* O; int ldc; const float* tab;
    __device__ __forceinline__ void operator()(const f32x4 (&acc)[2][2][4][2], const Unit& u, int wr, int wc, int fr, int fq) const {
        const int row0 = u.pm * BM + wr * 64 + fr; const int col0 = u.pn * BM + wc * 32 + 8 * fq;
#pragma unroll
        for (int bj = 0; bj < 2; ++bj) {
            const int g32 = u.pn * 8 + bj * 4 + wc, gi = g32 % 6;
            const bool rope = gi >= 4;
#pragma unroll
            for (int ai = 0; ai < 2; ++ai)
#pragma unroll
                for (int m = 0; m < 4; ++m) { const int row = row0 + ai * HALF + m * 16; bf16_t* rowp = O + (size_t)row * ldc + col0 + bj * HALF;
                    float v[8];
#pragma unroll
                    for (int e = 0; e < 4; ++e) { v[e] = acc[ai][bj][m][0][e]; v[4 + e] = acc[ai][bj][m][1][e]; }
                    if (rope) { const float* cs = tab + (size_t)(row & 4095) * 64 + (gi - 4) * 32 + (fq & 1) * 16;
                        const bool second = fq >= 2;
#pragma unroll
                        for (int q = 0; q < 4; ++q) { const f32x4 t4 = *(const GAS f32x4*)(cs + 4 * q);
#pragma unroll
                            for (int h = 0; h < 2; ++h) { const int e = 2 * q + h; const float c = h ? t4.z : t4.x, sn = h ? t4.w : t4.y;
                                auto rr = __builtin_amdgcn_permlane32_swap(__float_as_uint(v[e]), __float_as_uint(v[e]), false, false);
                                const float pv = __uint_as_float(second ? rr[0] : rr[1]);
                                v[e] = second ? (v[e] * c + pv * sn) : (v[e] * c - pv * sn); } } }
                    u32x4 w; w.x = cvt_pk_bf16(v[0], v[1]); w.y = cvt_pk_bf16(v[2], v[3]); w.z = cvt_pk_bf16(v[4], v[5]); w.w = cvt_pk_bf16(v[6], v[7]);
                    *(u32x4*)rowp = w; }
        }
    }
};
struct EpiF32 {
    static constexpr bool PERM = true;
    float* O; int ldc;
    __device__ __forceinline__ void operator()(const f32x4 (&acc)[2][2][4][2], const Unit& u, int wr, int wc, int fr, int fq) const {
        const int row0 = u.pm * BM + wr * 64 + fr; const int col0 = u.pn * BM + wc * 32 + 8 * fq;
#pragma unroll
        for (int ai = 0; ai < 2; ++ai)
#pragma unroll
            for (int m = 0; m < 4; ++m) { float* rowp = O + (size_t)(row0 + ai * HALF + m * 16) * ldc + col0;
#pragma unroll
                for (int bj = 0; bj < 2; ++bj) { *(f32x4*)(rowp + bj * HALF) = acc[ai][bj][m][0]; *(f32x4*)(rowp + bj * HALF + 4) = acc[ai][bj][m][1]; } }
    }
};
struct EpiSwiGLU {
    static constexpr bool PERM = true;
    bf16_t* O; int ldc;
    __device__ __forceinline__ void operator()(const f32x4 (&acc)[2][2][4][2], const Unit& u, int wr, int wc, int fr, int fq) const {
        const int row0 = u.pm * BM + wr * 64 + fr; const int col0 = u.pn * HALF + wc * 32 + 8 * fq;
#pragma unroll
        for (int ai = 0; ai < 2; ++ai)
#pragma unroll
            for (int m = 0; m < 4; ++m) { bf16_t* rowp = O + (size_t)(row0 + ai * HALF + m * 16) * ldc + col0;
                float o[8];
#pragma unroll
                for (int n = 0; n < 2; ++n)
#pragma unroll
                    for (int e = 0; e < 4; ++e) { const float a = acc[ai][0][m][n][e], gg = acc[ai][1][m][n][e]; o[n * 4 + e] = a * gg * __builtin_amdgcn_rcpf(1.f + __builtin_amdgcn_exp2f(a * -1.4426950408889634f)); }
                u32x4 w; w.x = cvt_pk_bf16(o[0], o[1]); w.y = cvt_pk_bf16(o[2], o[3]); w.z = cvt_pk_bf16(o[4], o[5]); w.w = cvt_pk_bf16(o[6], o[7]);
                *(u32x4*)rowp = w; }
    }
};
}
struct Args { const float* in[26]; float* out; unsigned char* ws; int ph_lo, ph_hi; };
struct Frame {
    LAS unsigned char* lds;
    volatile LAS unsigned* MISC;
    gu32* ctl;
    unsigned char* ws;
    int tid, lane, wave, vcu, G;
    float* out;
};
#define WSP(T, off) ((T*)(F.ws + (off)))

#ifndef MOE_ORDER
#define MOE_ORDER 0
#endif
namespace pg8 {
template <bool GATHER> struct MoeOrder {
    int nMe, nN, nwg, G, c, brows; const int* ridx;
    __device__ void init(int nMe_, int nN_, int brows_, const int* ridx_, int G_, int c_) { nMe = nMe_; nN = nN_; nwg = NE * nMe * nN; brows = brows_; ridx = ridx_; G = G_; c = c_; }
    __device__ bool next(int i, Unit& u) const {
        const long L = (long)i * G + c; if (L >= nwg) return false;
        const int wgid = xcd_remap((int)L, nwg), per = nMe * nN, e = wgid / per, rem = wgid % per;
        u.g = e;
#if MOE_ORDER == 1
        u.pm = e * nMe + rem / nN; u.pn = rem % nN;
#else
        u.pm = e * nMe + rem % nMe; u.pn = rem / nMe;
#endif
        u.skiphi = (nMe == 9 && (u.pm - e * nMe) == 8) ? 1 : 0;
        return true;
    }
    __device__ __forceinline__ unsigned arow(const Unit& u, int r) const {
        if constexpr (GATHER) return (unsigned)__hip_atomic_load(ridx + u.pm * BM + r, __ATOMIC_RELAXED, __HIP_MEMORY_SCOPE_AGENT);
        else return (unsigned)(u.pm * BM + r);
    }
    __device__ __forceinline__ unsigned acol2(const Unit&) const { return 0u; }
    __device__ __forceinline__ size_t boff(const Unit& u, int ldb) const { return ((size_t)u.g * brows + (size_t)u.pn * BM) * ldb; }
};
struct PoolOrder {
    int nM, nwg, G, c;
    __device__ void init(int nM_, int G_, int c_) { nM = nM_; nwg = nM * 4; G = G_; c = c_; }
    __device__ bool next(int i, Unit& u) const { const long L = (long)i * G + c; if (L >= nwg) return false; u.pm = (int)(L >> 2); u.g = (int)(L & 3); u.pn = 0; u.skiphi = 0; return true; }
    __device__ __forceinline__ unsigned arow(const Unit& u, int r) const { return (unsigned)(u.pm * BM + r); }
    __device__ __forceinline__ unsigned acol2(const Unit& u) const { return (unsigned)u.g * 512u; }
    __device__ __forceinline__ size_t boff(const Unit& u, int ldb) const { return (size_t)u.g * 256 * ldb; }
};
struct MlaInOrder {
    int nwg, G, c;
    __device__ void init(int G_, int c_) { nwg = 64 * 9 + 4 * 3; G = G_; c = c_; }
    __device__ bool next(int i, Unit& u) const {
        const long L = (long)i * G + c; if (L >= nwg) return false; u.g = 0; u.skiphi = 0;
        if (L < 576) { const int wgid = xcd_remap((int)L, 576); const int nig = WGM * 9, gid = wgid / nig, fm = gid * WGM; u.pm = fm + (wgid % nig) % WGM; u.pn = (wgid % nig) / WGM; }
        else { const int q = (int)L - 576; u.pm = 64 + q / 3; u.pn = 6 + q % 3; }
        return true;
    }
    __device__ __forceinline__ unsigned arow(const Unit& u, int r) const { return (unsigned)(u.pm * BM + r); }
    __device__ __forceinline__ unsigned acol2(const Unit&) const { return 0u; }
    __device__ __forceinline__ size_t boff(const Unit& u, int ldb) const { return (size_t)u.pn * BM * ldb; }
};
}

__device__ __forceinline__ float rope_inv_freq(int j) { return exp2f(-(float)j * (13.287712379549449f / 16.f)); }
__device__ __forceinline__ void cv_issue(float (&v)[32], const float* W, int ldn, int k0, int sc0, int lane) {
    const float* p = W + (size_t)(k0 + (lane >> 5)) * ldn + sc0 + (lane & 31);
#pragma unroll
    for (int i = 0; i < 32; ++i) v[i] = p[(size_t)(2 * i) * ldn];
}
__device__ __forceinline__ void cv_finish(float (&v)[32], bf16* WT, int KT, int dr0, int k0, const float* kscale, int lane) {
    const int h = lane >> 5, n = lane & 31;
    if (kscale) {
#pragma unroll
        for (int i = 0; i < 32; ++i) v[i] *= kscale[k0 + 2 * i + h];
    }
    unsigned w[16];
#pragma unroll
    for (int i = 0; i < 16; ++i) { auto rr = __builtin_amdgcn_permlane32_swap(__float_as_uint(v[i]), __float_as_uint(v[i + 16]), false, false);
        unsigned r; asm volatile("v_cvt_pk_bf16_f32 %0, %1, %2" : "=v"(r) : "v"(__uint_as_float(rr[0])), "v"(__uint_as_float(rr[1]))); w[i] = r; }
    bf16* dst = WT + ((size_t)((dr0 >> 8) * KT + (k0 >> 6)) * 256 + (dr0 & 255) + n) * 64 + 32 * h;
#pragma unroll
    for (int j = 0; j < 4; ++j) *(GAS v4u*)(dst + 8 * j) = (v4u){w[4 * j], w[4 * j + 1], w[4 * j + 2], w[4 * j + 3]};
}
__device__ __forceinline__ void transpose_item(const float* W, int ldn, int k0, int sc0, bf16* WT, int KT, int dr0, const float* kscale, int lane) {
    float v[32]; cv_issue(v, W, ldn, k0, sc0, lane); cv_finish(v, WT, KT, dr0, k0, kscale, lane);
}
constexpr int MOE_ITEMS = 3 * 32 * 2048 + 2 * 2048, MOE_ITEMS_SCAN = 68 * 256 * 8, MOE_SCAN2_STEPS = 30, MOE_ITEMS_SCAN2 = MOE_SCAN2_STEPS * 256 * 8;
static_assert(MOE_ITEMS_SCAN + MOE_ITEMS_SCAN2 == MOE_ITEMS, "the scan phase converts every item");
struct MoeItem { const float* src; bf16* dst; int k0, n0, dr0; };
__device__ __forceinline__ MoeItem moe_item(Frame& F, const Args& A, int m) {
    const int which = m >> 16, q = m & 65535, le = q >> 11, q2 = q & 2047, kb = q2 >> 6, nb = q2 & 63, n0 = 32 * nb;
    MoeItem it; it.k0 = 64 * kb; it.n0 = n0;
    const float* s1 = A.in[23]; const float* s3 = A.in[24]; const float* s2 = A.in[25];
    it.src = (which == 0 ? s1 : which == 1 ? s3 : s2) + (size_t)le * 2048 * 2048;
    it.dst = (which == 2) ? WSP(bf16, WS_WM2) + (size_t)le * 2048 * 2048 : WSP(bf16, WS_WM13) + (size_t)le * 4096 * 2048;
    it.dr0 = (which >= 2) ? n0 : (n0 >> 7) * 256 + (n0 & 127) + which * 128;
    if (which == 3) { it.src = le == 0 ? A.in[15] : A.in[21]; it.dst = le == 0 ? WSP(bf16, WS_WOUT0) : WSP(bf16, WS_WO); }
    return it;
}
__device__ __forceinline__ void p0_prologue(Frame& F, const Args& A) {
    LAS float* scond = (LAS float*)(F.lds + 73728);
    LAS float* red = (LAS float*)(F.lds + 73728 + 40960);
    for (int i = F.tid; i < 5 * 2048; i += 512) { const int r = i >> 11, k = i & 2047; const float v = (r < 4) ? A.in[1][r * 2048 + k] : A.in[3][k]; scond[i] = siluf(v); }
    __syncthreads();
    float* MOD = WSP(float, WS_MOD);
    for (int j = 0; j < 2; ++j) {
        const int tk = F.vcu + 256 * j;
        if (tk < 384) {
            const int l = tk / 192, col0 = (tk % 192) * 64;
            const float* W = A.in[4] + (size_t)l * 2048 * 12288 + col0 + F.lane;
            float a0 = 0.f, a1 = 0.f, a2 = 0.f, a3 = 0.f, a4 = 0.f;
            const int kb = F.wave * 256;
#pragma unroll 8
            for (int k = 0; k < 256; ++k) { const float w = W[(size_t)(kb + k) * 12288];
                a0 += scond[0 * 2048 + kb + k] * w; a1 += scond[1 * 2048 + kb + k] * w; a2 += scond[2 * 2048 + kb + k] * w; a3 += scond[3 * 2048 + kb + k] * w; a4 += scond[4 * 2048 + kb + k] * w; }
            red[(F.wave * 5 + 0) * 64 + F.lane] = a0; red[(F.wave * 5 + 1) * 64 + F.lane] = a1; red[(F.wave * 5 + 2) * 64 + F.lane] = a2; red[(F.wave * 5 + 3) * 64 + F.lane] = a3; red[(F.wave * 5 + 4) * 64 + F.lane] = a4;
        }
        __syncthreads();
        if (tk < 384 && F.tid < 320) {
            const int l = tk / 192, col0 = (tk % 192) * 64, r = F.tid >> 6, cc = F.tid & 63;
            float s = A.in[5][l * 12288 + col0 + cc];
#pragma unroll
            for (int w = 0; w < 8; ++w) s += red[(w * 5 + r) * 64 + cc];
            MOD[(size_t)(l * 5 + r) * 12288 + col0 + cc] = s;
        }
        __syncthreads();
    }
    for (int gid = F.vcu * 512 + F.tid; gid < 4096 * 32; gid += F.G * 512) {
        const int t = gid >> 5, a = (gid >> 4) & 1, j = gid & 15; float sn, cs; sincosf((float)(a ? (t & 63) : (t >> 6)) * rope_inv_freq(j), &sn, &cs);
        *(f32x2*)(WSP(float, WS_ROPE) + (size_t)gid * 2) = (f32x2){cs, sn}; }
    const int gw = F.vcu * NWAVES + F.wave, NGW = F.G * NWAVES;
    constexpr int I_IN0 = 32 * 160, I_OUT0 = 32 * 64, I_POOL = 4 * 4 * 8, I_MIN = 32 * 66, I_MINZ = 6 * 32, I_UQ = 24 * 96, I_UKV = 8 * 128, I_O = 32 * 64, I_E = 32 * 64;
    constexpr int I_SMALL = I_IN0 + I_POOL + I_MIN + I_MINZ + I_UQ + I_UKV;
    constexpr int I_GATE = 32; constexpr int NITEMS = I_SMALL + I_GATE;
    for (int it = gw; it < NITEMS; it += NGW) {
        int r = it;
        if (r < I_IN0) { const int kb = r / 160, nb = r % 160, dr = 32 * nb; transpose_item(A.in[8], INAB, 64 * kb, dr < 4096 ? dr : dr + 16, WSP(bf16, WS_WIN0), 32, dr, nullptr, F.lane); continue; } r -= I_IN0;
        if (r < I_POOL) { const int gq = r / 32, q = r % 32, kb = q / 8, nb = q % 8; transpose_item(A.in[13] + gq * 65536, 256, 64 * kb, 32 * nb, WSP(bf16, WS_WPOOL) + gq * 65536, 4, 32 * nb, nullptr, F.lane); continue; } r -= I_POOL;
        if (r < I_MIN) { const int kb = r / 66, nb = r % 66; transpose_item(A.in[16], INC, 64 * kb, 32 * nb, WSP(bf16, WS_WMIN), 32, 32 * nb, nullptr, F.lane); continue; } r -= I_MIN;
        if (r < I_MINZ) { const int rb = r / 32, kb = r % 32; bf16* Z = WSP(bf16, WS_WMIN) + ((size_t)(8 * 32 + kb) * 256 + 64 + 32 * rb) * 64;
#pragma unroll
            for (int j = 0; j < 4; ++j) { const int n = (F.lane >> 3) + 8 * j; *(GAS v4u*)(Z + n * 64 + 8 * (F.lane & 7)) = (v4u){0u, 0u, 0u, 0u}; }
            continue; } r -= I_MINZ;
        if (r < I_UQ) { const int kb = r / 96, nb = r % 96; transpose_item(A.in[19], 3072, 64 * kb, 32 * nb, WSP(bf16, WS_WUQ), 24, 32 * nb, A.in[17], F.lane); continue; } r -= I_UQ;
        if (r < I_UKV) { const int kb = r / 128, nb = r % 128; transpose_item(A.in[20], 4096, 64 * kb, 32 * nb, WSP(bf16, WS_WUKV), 8, 32 * nb, A.in[18], F.lane); continue; } r -= I_UKV;
        transpose_item(A.in[8], INAB, 64 * r, 4096, WSP(bf16, WS_WIN0), 32, 5120, nullptr, F.lane);
    }
}

__device__ __forceinline__ const float* mod_ptr(Frame& F, const Args& A, int layer, int brow, int k) { return WSP(float, WS_MOD) + (size_t)(layer * 5 + brow) * 12288 + k * 2048; }
__device__ __forceinline__ int brow_of(int r) { return r < NL ? (r >> 12) : 4; }
__device__ __forceinline__ void store_bf16_row(bf16* orow, const f32x4 (&v)[8], int lane) {
    GAS unsigned long long* o8 = (GAS unsigned long long*)orow + lane;
#pragma unroll
    for (int j = 0; j < 8; ++j) o8[64 * j] = (unsigned long long)pk2(v[j].x, v[j].y) | ((unsigned long long)pk2(v[j].z, v[j].w) << 32);
}
typedef float f32x2 __attribute__((ext_vector_type(2)));
__device__ __forceinline__ int rd16_col(int lane) { return 4 * (lane & 3) + (lane >> 4); }
__device__ __forceinline__ float row_dot16(const f32x4 (&v)[8], const LAS float* wT, int lane) {
    float mine = 0.f;
#pragma unroll 1
    for (int g = 0; g < 4; ++g) { float s[4];
#pragma unroll
        for (int c = 0; c < 4; ++c) { f32x2 a0 = (f32x2){0.f, 0.f}, a1 = (f32x2){0.f, 0.f};
#pragma unroll
            for (int j = 0; j < 8; ++j) { const f32x4 w = *(const LAS f32x4*)(wT + (g * 4 + c) * 2048 + j * 256 + lane * 4);
                a0 = __builtin_elementwise_fma((f32x2){v[j].x, v[j].y}, (f32x2){w.x, w.y}, a0); a1 = __builtin_elementwise_fma((f32x2){v[j].z, v[j].w}, (f32x2){w.z, w.w}, a1); }
            a0 += a1; s[c] = a0.x + a0.y;
            if (c == 1) asm volatile("" ::: "memory");
        }
        float p, q, r;
        { auto rr = __builtin_amdgcn_permlane32_swap(__float_as_uint(s[0]), __float_as_uint(s[2]), false, false); p = __uint_as_float(rr[0]) + __uint_as_float(rr[1]); }
        { auto rr = __builtin_amdgcn_permlane32_swap(__float_as_uint(s[1]), __float_as_uint(s[3]), false, false); q = __uint_as_float(rr[0]) + __uint_as_float(rr[1]); }
        { auto rr = __builtin_amdgcn_permlane16_swap(__float_as_uint(p), __float_as_uint(q), false, false); r = __uint_as_float(rr[0]) + __uint_as_float(rr[1]); }
        r += dpp_mov<0xB1>(r); r += dpp_mov<0x4E>(r); r += dpp_mov<0x141>(r); r += dpp_mov<0x140>(r);
        mine = ((lane & 3) == g) ? r : mine; }
    return mine;
}
__device__ __forceinline__ float rd16_max(float x) {
    x = fmaxf(x, dpp_mov<0xB1>(x)); x = fmaxf(x, dpp_mov<0x4E>(x));
    { auto rr = __builtin_amdgcn_permlane16_swap(__float_as_uint(x), __float_as_uint(x), false, false); x = fmaxf(__uint_as_float(rr[0]), __uint_as_float(rr[1])); }
    { auto rr = __builtin_amdgcn_permlane32_swap(__float_as_uint(x), __float_as_uint(x), false, false); x = fmaxf(__uint_as_float(rr[0]), __uint_as_float(rr[1])); }
    return x;
}
__device__ __forceinline__ float rd16_sum(float x) {
    x += dpp_mov<0xB1>(x); x += dpp_mov<0x4E>(x);
    { auto rr = __builtin_amdgcn_permlane16_swap(__float_as_uint(x), __float_as_uint(x), false, false); x = __uint_as_float(rr[0]) + __uint_as_float(rr[1]); }
    { auto rr = __builtin_amdgcn_permlane32_swap(__float_as_uint(x), __float_as_uint(x), false, false); x = __uint_as_float(rr[0]) + __uint_as_float(rr[1]); }
    return x;
}
__device__ __forceinline__ void load_wT16(Frame& F, const Args& A, const float* src, int ld, LAS float* wT) {
    f32x4 w[4][4];
#pragma unroll
    for (int m = 0; m < 4; ++m) { const float* p = src + (size_t)(F.tid + 512 * m) * ld;
#pragma unroll
        for (int q = 0; q < 4; ++q) w[m][q] = *(const f32x4*)(p + 4 * q); }
#pragma unroll
    for (int m = 0; m < 4; ++m) { const int k = F.tid + 512 * m;
#pragma unroll
        for (int q = 0; q < 4; ++q) { wT[(4 * q + 0) * 2048 + k] = w[m][q].x; wT[(4 * q + 1) * 2048 + k] = w[m][q].y; wT[(4 * q + 2) * 2048 + k] = w[m][q].z; wT[(4 * q + 3) * 2048 + k] = w[m][q].w; } }
    __syncthreads();
}
__device__ __forceinline__ void ln_affine(f32x4 (&v)[8], const float* g, const float* b, int lane) {
    float s = 0.f;
#pragma unroll
    for (int j = 0; j < 8; ++j) s += (v[j].x + v[j].y) + (v[j].z + v[j].w);
    const float mean = wave_sum(s) * (1.f / 2048.f); float s2 = 0.f;
#pragma unroll
    for (int j = 0; j < 8; ++j) { v[j] = v[j] - mean; s2 += (v[j].x * v[j].x + v[j].y * v[j].y) + (v[j].z * v[j].z + v[j].w * v[j].w); }
    const float rstd = 1.f / sqrtf(wave_sum(s2) * (1.f / 2048.f) + LN_EPS);
#pragma unroll
    for (int j = 0; j < 8; ++j) { const f32x4 gg = *(const f32x4*)(g + j * 256 + lane * 4), bb = *(const f32x4*)(b + j * 256 + lane * 4); v[j] = v[j] * rstd * gg + bb; }
}

__device__ __forceinline__ void stage_gb(Frame& F, LAS float* gb, const float* g, const float* b) {
    *(LAS f32x4*)(gb + F.tid * 4) = *(const f32x4*)(g + F.tid * 4); *(LAS f32x4*)(gb + 2048 + F.tid * 4) = *(const f32x4*)(b + F.tid * 4);
}
__device__ __forceinline__ void ln_affine_lds(f32x4 (&v)[8], const LAS float* gb, int lane) {
    float s = 0.f;
#pragma unroll
    for (int j = 0; j < 8; ++j) s += (v[j].x + v[j].y) + (v[j].z + v[j].w);
    const float mean = wave_sum(s) * (1.f / 2048.f); float s2 = 0.f;
#pragma unroll
    for (int j = 0; j < 8; ++j) { v[j] = v[j] - mean; s2 += (v[j].x * v[j].x + v[j].y * v[j].y) + (v[j].z * v[j].z + v[j].w * v[j].w); }
    const float rstd = 1.f / sqrtf(wave_sum(s2) * (1.f / 2048.f) + LN_EPS);
#pragma unroll
    for (int j = 0; j < 8; ++j) { const f32x4 gg = *(const LAS f32x4*)(gb + j * 256 + lane * 4), bb = *(const LAS f32x4*)(gb + 2048 + j * 256 + lane * 4); v[j] = v[j] * rstd * gg + bb; }
}

__device__ __forceinline__ void ph_mod0(Frame& F, const Args& A) {
    const int gw = F.vcu * NWAVES + F.wave, NGW = F.G * NWAVES;
    bf16* H = WSP(bf16, WS_H);
    f32x4 xn[8];
#define M0_LOAD(rr) do { const int r_ = (rr); const float* xr_ = (r_ < NL) ? A.in[0] + (size_t)r_ * DM : A.in[2] + (size_t)(r_ - NL) * DM; \
        _Pragma("unroll") for (int j = 0; j < 8; ++j) xn[j] = *(const f32x4*)(xr_ + j * 256 + F.lane * 4); } while (0)
    if (gw < R0) M0_LOAD(gw);
    for (int r = gw; r < R0; r += NGW) {
        const int br = brow_of(r); const float* sh = mod_ptr(F, A, 0, br, 0); const float* sc = mod_ptr(F, A, 0, br, 1);
        f32x4 s1[8], s0[8], x[8];
#pragma unroll
        for (int j = 0; j < 8; ++j) { const int col = j * 256 + F.lane * 4; s1[j] = *(const GAS f32x4*)(sc + col); s0[j] = *(const GAS f32x4*)(sh + col); x[j] = xn[j]; }
        asm volatile("" : "+v"(x[0]), "+v"(x[1]), "+v"(x[2]), "+v"(x[3]), "+v"(x[4]), "+v"(x[5]), "+v"(x[6]), "+v"(x[7]) :: "memory");
        { const int rn = (r + NGW < R0) ? r + NGW : r; M0_LOAD(rn); }
        asm volatile("" ::: "memory");
        f32x4 v[8];
#pragma unroll
        for (int j = 0; j < 8; ++j) v[j] = x[j] * (1.f + s1[j]) + s0[j];
        store_bf16_row(H + (size_t)r * DM, v, F.lane);
    }
#undef M0_LOAD
}

__device__ __forceinline__ void unpk8(const v4u z, float (&o)[8]) {
#pragma unroll
    for (int e = 0; e < 4; ++e) { o[2 * e] = bflo(z[e]); o[2 * e + 1] = bfhi(z[e]); }
}
template <int HWMAX>
__device__ __forceinline__ void pool_item(const bf16* PB, bf16* PU, int r0, int t0, int T, int col, int lane) {
    const int gq = col >> 8, hw = 1 << gq;
    constexpr int NR = 2 * HWMAX + 3;
    const bf16* ub = PB + (size_t)r0 * PW + 4096 + col;
    v4u z[NR];
#pragma unroll
    for (int i = 0; i < NR; ++i) { const int t = t0 - HWMAX + i; z[i] = (t >= 0 && t < T) ? *(const GAS v4u*)(ub + (ptrdiff_t)(i - HWMAX) * PW) : (v4u){0u, 0u, 0u, 0u}; }
    float sa[8], sb[8];
#pragma unroll
    for (int e = 0; e < 8; ++e) { sa[e] = 0.f; sb[e] = 0.f; }
#pragma unroll
    for (int q = -HWMAX; q < HWMAX; ++q) { float u[8]; unpk8(z[q + HWMAX], u);
#pragma unroll
        for (int e = 0; e < 8; ++e) { sb[e] += u[e]; if (q >= -HWMAX / 2 && q < HWMAX / 2) sa[e] += u[e]; } }
    const bool big = (hw == HWMAX);
#pragma unroll
    for (int i = 0; i < 4; ++i) {
        const int t = t0 + i; int lo = t - hw, hi = t + hw; lo = lo < 0 ? 0 : lo; hi = hi > T ? T : hi;
        const float inv = 1.f / (float)(hi - lo);
        float c[8]; unpk8(z[i + HWMAX], c); float o[8];
#pragma unroll
        for (int e = 0; e < 8; ++e) o[e] = (big ? sb[e] : sa[e]) * inv - c[e];
        v4u w; w.x = pk2(o[0], o[1]); w.y = pk2(o[2], o[3]); w.z = pk2(o[4], o[5]); w.w = pk2(o[6], o[7]);
        *(GAS v4u*)(PU + (size_t)(r0 + i) * 1024 + col) = w;
        if (i < 3) {
            float p1[8], m1[8], p2[8], m2[8]; unpk8(z[i + HWMAX + HWMAX], p2); unpk8(z[i], m2); unpk8(z[i + HWMAX + HWMAX / 2], p1); unpk8(z[i + HWMAX - HWMAX / 2], m1);
#pragma unroll
            for (int e = 0; e < 8; ++e) { sb[e] += p2[e] - m2[e]; sa[e] += p1[e] - m1[e]; }
        }
    }
}
__device__ __forceinline__ void ph_conv_pool(Frame& F, const Args& A) {
    const int gw = F.vcu * NWAVES + F.wave, NGW = F.G * NWAVES;
    const bf16* PB = WSP(bf16, WS_PB); bf16* QK = WSP(bf16, WS_QK); bf16* PU = WSP(bf16, WS_PU);
    constexpr int NSTRIP = R0 / 4;
    for (int it = gw; it < NSTRIP * 6; it += NGW) {
        const int jj = it / NSTRIP, strip = it % NSTRIP, r0 = strip * 4;
        int t0, T; if (r0 < NL) { t0 = r0 & 4095; T = SEQ; } else { t0 = (r0 - NL) & 255; T = CTXL; }
        if (jj < 4) {
            const int col = jj * 512 + F.lane * 8;
            float wm[8], wc[8], wp[8], bb[8];
#pragma unroll
            for (int h = 0; h < 2; ++h) { const f32x4 a = *(const f32x4*)(A.in[9] + col + 4 * h), b = *(const f32x4*)(A.in[9] + 2048 + col + 4 * h), c = *(const f32x4*)(A.in[9] + 4096 + col + 4 * h), d = *(const f32x4*)(A.in[10] + col + 4 * h);
#pragma unroll
                for (int e = 0; e < 4; ++e) { wm[4 * h + e] = a[e]; wc[4 * h + e] = b[e]; wp[4 * h + e] = c[e]; bb[4 * h + e] = d[e]; } }
            const bf16* p0 = PB + (size_t)r0 * PW + col;
            v4u z[6];
#pragma unroll
            for (int i = 0; i < 6; ++i) { const int t = t0 - 1 + i; z[i] = (t >= 0 && t < T) ? *(const GAS v4u*)(p0 + (ptrdiff_t)(i - 1) * PW) : (v4u){0u, 0u, 0u, 0u}; }
            const float ksc = (col >= 1024) ? 0.0625f : 1.f;
#pragma unroll
            for (int i = 0; i < 4; ++i) { float pm[8], pc[8], pp[8], o[8]; unpk8(z[i], pm); unpk8(z[i + 1], pc); unpk8(z[i + 2], pp);
#pragma unroll
                for (int e = 0; e < 8; ++e) { const float a = wm[e] * pm[e] + wc[e] * pc[e] + wp[e] * pp[e] + bb[e]; o[e] = siluf(a) * ksc; }
                v4u w; w.x = pk2(o[0], o[1]); w.y = pk2(o[2], o[3]); w.z = pk2(o[4], o[5]); w.w = pk2(o[6], o[7]);
                *(GAS v4u*)(QK + (size_t)(r0 + i) * 2048 + col) = w; }
        } else if (jj == 4) pool_item<2>(PB, PU, r0, t0, T, F.lane * 8, F.lane);
        else pool_item<8>(PB, PU, r0, t0, T, 512 + F.lane * 8, F.lane);
    }
}

__device__ __forceinline__ void ph_readout(Frame& F, const Args& A) {
    const int gw = F.vcu * NWAVES + F.wave, NGW = F.G * NWAVES;
    const bf16* HF = WSP(bf16, WS_HF); const bf16* HB = HF + (size_t)R0 * 1024; const bf16* PB = WSP(bf16, WS_PB); bf16* A2 = WSP(bf16, WS_A2);
    f32x4 hg[4];
#pragma unroll
    for (int jj = 0; jj < 4; ++jj) hg[jj] = *(const f32x4*)(A.in[12] + jj * 256 + F.lane * 4);
    v2u hfn[4], hbn[4], own[4];
#define RO_LOAD(rr) do { const int r_ = (rr); _Pragma("unroll") for (int jj = 0; jj < 4; ++jj) { const int col = jj * 256 + F.lane * 4; \
        hfn[jj] = *(const GAS v2u*)(HF + (size_t)r_ * 1024 + col); hbn[jj] = *(const GAS v2u*)(HB + (size_t)r_ * 1024 + col); own[jj] = *(const GAS v2u*)(PB + (size_t)r_ * PW + 3072 + col); } } while (0)
    if (gw < R0) RO_LOAD(gw);
    for (int r = gw; r < R0; r += NGW) {
        v2u hf[4], hb[4], ow[4];
#pragma unroll
        for (int jj = 0; jj < 4; ++jj) { hf[jj] = hfn[jj]; hb[jj] = hbn[jj]; ow[jj] = own[jj]; }
        asm volatile("" : "+v"(hf[0]), "+v"(hf[1]), "+v"(hf[2]), "+v"(hf[3]), "+v"(hb[0]), "+v"(hb[1]), "+v"(hb[2]), "+v"(hb[3]), "+v"(ow[0]), "+v"(ow[1]), "+v"(ow[2]), "+v"(ow[3]) :: "memory");
        { const int rn = (r + NGW < R0) ? r + NGW : r; RO_LOAD(rn); }
        asm volatile("" ::: "memory");
#pragma unroll
        for (int jj = 0; jj < 4; ++jj) {
            const int col = jj * 256 + F.lane * 4;
            f32x4 v = (f32x4){bflo(hf[jj].x) + bflo(hb[jj].x), bfhi(hf[jj].x) + bfhi(hb[jj].x), bflo(hf[jj].y) + bflo(hb[jj].y), bfhi(hf[jj].y) + bfhi(hb[jj].y)};
            const float mean = wave_sum((v.x + v.y) + (v.z + v.w)) * (1.f / 256.f);
            v = v - mean;
            const float rstd = 1.f / sqrtf(wave_sum((v.x * v.x + v.y * v.y) + (v.z * v.z + v.w * v.w)) * (1.f / 256.f) + LN_EPS);
            f32x4 o; o.x = v.x * rstd * hg[jj].x * sigmoidf_(bflo(ow[jj].x)); o.y = v.y * rstd * hg[jj].y * sigmoidf_(bfhi(ow[jj].x)); o.z = v.z * rstd * hg[jj].z * sigmoidf_(bflo(ow[jj].y)); o.w = v.w * rstd * hg[jj].w * sigmoidf_(bfhi(ow[jj].y));
            *(GAS unsigned long long*)(A2 + (size_t)r * 2048 + col) = (unsigned long long)pk2(o.x, o.y) | ((unsigned long long)pk2(o.z, o.w) << 32);
        }
    }
#undef RO_LOAD
}

__device__ __forceinline__ void ph_post1(Frame& F, const Args& A, int layer, int first, int step, int rend, unsigned* rdy, unsigned need, int blk_lo, int blk_hi) {
    LAS float* wT = (LAS float*)F.lds; LAS float* gb = (LAS float*)(F.lds + 131072);
    stage_gb(F, gb, A.in[6] + (size_t)(layer * 2 + 0) * 2048, A.in[7] + (size_t)(layer * 2 + 0) * 2048);
    load_wT16(F, A, A.in[22] + (size_t)layer * 2048 * 16, 16, wT);
    bf16* X1 = WSP(bf16, WS_X1); const bf16* Y = WSP(bf16, WS_Y); bf16* H = WSP(bf16, WS_H); float* AFF = WSP(float, WS_AFF);
    f32x4 xn[8]; v2u yn[8];
#define P1_LOAD(rr) do { const int r_ = (rr); const float* xr_ = (r_ < NL) ? A.in[0] + (size_t)r_ * DM : A.in[2] + (size_t)(r_ - NL) * DM; \
        _Pragma("unroll") for (int j = 0; j < 8; ++j) { const int col = j * 256 + F.lane * 4; \
            if (layer == 0) xn[j] = *(const GAS f32x4*)(xr_ + col); else { const v2u xw_ = *(const GAS v2u*)(X1 + (size_t)r_ * DM + col); xn[j] = (f32x4){bflo(xw_.x), bfhi(xw_.x), bflo(xw_.y), bfhi(xw_.y)}; } \
            yn[j] = *(const GAS v2u*)(Y + (size_t)r_ * DM + col); } } while (0)
    if (rdy) {
        if (F.wave == 0) { unsigned* bar = (unsigned*)(F.ctl + CW_BAR);
            for (int b0 = blk_lo; b0 <= blk_hi; b0 += 64) { const int blk = b0 + F.lane; XB_SPIN(!__all(blk > blk_hi || xb_ld(rdy + blk) >= need), bar); }
            __builtin_amdgcn_fence(__ATOMIC_ACQUIRE, "agent"); asm volatile("s_waitcnt vmcnt(0)" ::: "memory"); }
        __syncthreads();
    }
    if (first < rend) P1_LOAD(first);
    for (int r = first; r < rend; r += step) {
        const int br = brow_of(r); const float* ga = mod_ptr(F, A, layer, br, 2); const float* shf = mod_ptr(F, A, layer, br, 3); const float* scf = mod_ptr(F, A, layer, br, 4);
        f32x4 g1[8], s1[8], s0[8];
#pragma unroll
        for (int j = 0; j < 8; ++j) { const int col = j * 256 + F.lane * 4; g1[j] = *(const GAS f32x4*)(ga + col); }
        f32x4 v[8];
#pragma unroll
        for (int j = 0; j < 8; ++j) { const f32x4 yv = (f32x4){bflo(yn[j].x), bfhi(yn[j].x), bflo(yn[j].y), bfhi(yn[j].y)}; v[j] = xn[j] * ALPHA + (1.f + g1[j]) * yv; }
        asm volatile("" : "+v"(v[0]), "+v"(v[1]), "+v"(v[2]), "+v"(v[3]), "+v"(v[4]), "+v"(v[5]), "+v"(v[6]), "+v"(v[7]) :: "memory");
#pragma unroll
        for (int j = 0; j < 8; ++j) { const int col = j * 256 + F.lane * 4; s1[j] = *(const GAS f32x4*)(scf + col); s0[j] = *(const GAS f32x4*)(shf + col); }
        asm volatile("" ::: "memory");
        { const int rn = (r + step < rend) ? r + step : r; P1_LOAD(rn); }
        asm volatile("" ::: "memory");
        ln_affine_lds(v, gb, F.lane);
        store_bf16_row(X1 + (size_t)r * DM, v, F.lane);
#pragma unroll
        for (int j = 0; j < 8; ++j) v[j] = v[j] * (1.f + s1[j]) + s0[j];
        store_bf16_row(H + (size_t)r * DM, v, F.lane);
        const float lgt = row_dot16(v, wT, F.lane);
        const float mx = rd16_max(lgt); const float o = expf(lgt - mx); const float sum = rd16_sum(o);
        if ((F.lane & 12) == 0) AFF[(size_t)r * 16 + rd16_col(F.lane)] = o / sum;
    }
#undef P1_LOAD
}

__device__ __forceinline__ void ph_combine(Frame& F, const Args& A, int layer, int nrows, int slots) {
    const int gw = F.vcu * NWAVES + F.wave, NGW = F.G * NWAVES;
    bf16* X1 = WSP(bf16, WS_X1); bf16* H = WSP(bf16, WS_H); const bf16* YS = WSP(bf16, WS_YS); const int* RSLOT = WSP(int, WS_RSLOT);
    LAS float* gb = (LAS float*)F.lds;
    __syncthreads(); stage_gb(F, gb, A.in[6] + (size_t)(layer * 2 + 1) * 2048, A.in[7] + (size_t)(layer * 2 + 1) * 2048); __syncthreads();
    const float* AFF = WSP(float, WS_AFF);
    f32x4 xn[8]; int slot_n = -1; float aff_n = 0.f;
#define CB_LOAD(rr) do { const int r_ = (rr); slot_n = (F.lane < 16) ? __hip_atomic_load(RSLOT + (size_t)r_ * 16 + F.lane, __ATOMIC_RELAXED, __HIP_MEMORY_SCOPE_AGENT) : -1; \
        aff_n = *(const GAS float*)(AFF + (size_t)r_ * 16 + (F.lane & 15)); \
        _Pragma("unroll") for (int j = 0; j < 8; ++j) { const v2u xw_ = *(const GAS v2u*)(X1 + (size_t)r_ * DM + j * 256 + F.lane * 4); xn[j] = (f32x4){bflo(xw_.x), bfhi(xw_.x), bflo(xw_.y), bfhi(xw_.y)}; } } while (0)
    if (gw < nrows) CB_LOAD(gw);
    for (int r = gw; r < nrows; r += NGW) {
        const int br = brow_of(r); const float* gaf = mod_ptr(F, A, layer, br, 5);
        f32x4 f[8];
#pragma unroll
        for (int j = 0; j < 8; ++j) f[j] = (f32x4){0.f, 0.f, 0.f, 0.f};
        const int myslot = slot_n; const int myaff = __float_as_int(aff_n);
        unsigned mask = (unsigned)__ballot(myslot >= 0) & 0xffffu;
        while (mask) {
            const int e1 = __builtin_ctz(mask); mask &= mask - 1u;
            const bool two = mask != 0u; const int e2 = two ? __builtin_ctz(mask) : e1; if (two) mask &= mask - 1u;
            const int s1 = __builtin_amdgcn_readlane(myslot, e1), s2 = __builtin_amdgcn_readlane(myslot, e2);
            const bf16* y1 = YS + ((size_t)e1 * slots + s1) * 2048; const bf16* y2 = YS + ((size_t)e2 * slots + s2) * 2048;
            v2u w1[8], w2[8];
#pragma unroll
            for (int j = 0; j < 8; ++j) { w1[j] = *(const GAS v2u*)(y1 + j * 256 + F.lane * 4); w2[j] = *(const GAS v2u*)(y2 + j * 256 + F.lane * 4); }
            const float k1 = __int_as_float(__builtin_amdgcn_readlane(myaff, e1)), k2 = two ? __int_as_float(__builtin_amdgcn_readlane(myaff, e2)) : 0.f;
#pragma unroll
            for (int j = 0; j < 8; ++j) { f[j].x += k1 * bflo(w1[j].x) + k2 * bflo(w2[j].x); f[j].y += k1 * bfhi(w1[j].x) + k2 * bfhi(w2[j].x); f[j].z += k1 * bflo(w1[j].y) + k2 * bflo(w2[j].y); f[j].w += k1 * bfhi(w1[j].y) + k2 * bfhi(w2[j].y); }
        }
        f32x4 v[8];
#pragma unroll
        for (int j = 0; j < 8; ++j) { const int col = j * 256 + F.lane * 4; const f32x4 g1 = *(const GAS f32x4*)(gaf + col); v[j] = xn[j] * ALPHA + (1.f + g1) * f[j]; }
        asm volatile("" : "+v"(v[0]), "+v"(v[1]), "+v"(v[2]), "+v"(v[3]), "+v"(v[4]), "+v"(v[5]), "+v"(v[6]), "+v"(v[7]) :: "memory");
        f32x4 s1v[8], s0v[8];
        if (layer == 0) { const float* sh = mod_ptr(F, A, 1, br, 0); const float* sc = mod_ptr(F, A, 1, br, 1);
#pragma unroll
            for (int j = 0; j < 8; ++j) { const int col = j * 256 + F.lane * 4; s1v[j] = *(const GAS f32x4*)(sc + col); s0v[j] = *(const GAS f32x4*)(sh + col); } }
        asm volatile("" ::: "memory");
        { const int rn = (r + NGW < nrows) ? r + NGW : r; CB_LOAD(rn); }
        asm volatile("" ::: "memory");
        ln_affine_lds(v, gb, F.lane);
        if (layer == 0) {
            store_bf16_row(X1 + (size_t)r * DM, v, F.lane);
#pragma unroll
            for (int j = 0; j < 8; ++j) v[j] = v[j] * (1.f + s1v[j]) + s0v[j];
            store_bf16_row(H + (size_t)r * DM, v, F.lane);
        } else {
#pragma unroll
            for (int j = 0; j < 8; ++j) *(f32x4*)(F.out + (size_t)r * DM + j * 256 + F.lane * 4) = v[j];
        }
    }
}

#undef CB_LOAD
__device__ __forceinline__ void ph_mla_norm(Frame& F, const Args& A) {
    const int gw = F.vcu * NWAVES + F.wave, NGW = F.G * NWAVES;
    const bf16* PL = WSP(bf16, WS_PL); bf16* QN = WSP(bf16, WS_QN); bf16* KVN = WSP(bf16, WS_KVN); bf16* KPE = WSP(bf16, WS_KPE);
    const int l = F.lane & 7;
    v4u zqn[3], zkn, zrn; f32x4 tbn[4];
#define MN_LOAD(rr) do { const int r_ = (rr); const bf16* pr_ = PL + (size_t)r_ * PLW; const int t_ = (r_ < NL) ? (r_ & 4095) : ((r_ - NL) & 255); \
        _Pragma("unroll") for (int jj = 0; jj < 3; ++jj) zqn[jj] = *(const GAS v4u*)(pr_ + jj * 512 + F.lane * 8); \
        zkn = *(const GAS v4u*)(pr_ + 1536 + F.lane * 8); zrn = *(const GAS v4u*)(pr_ + 2048 + l * 8); \
        const float* cst_ = WSP(float, WS_ROPE) + (size_t)t_ * 64 + (l >> 2) * 32 + (l & 1) * 16; \
        _Pragma("unroll") for (int q = 0; q < 4; ++q) tbn[q] = *(const GAS f32x4*)(cst_ + 4 * q); } while (0)
    if (gw < R0) MN_LOAD(gw);
    for (int r = gw; r < R0; r += NGW) {
        int b, t, kvrow; const bool lat = r < NL;
        if (lat) { b = r >> 12; t = r & 4095; kvrow = b * KVS + CTXL + t; } else { b = (r - NL) >> 8; t = (r - NL) & 255; kvrow = b * KVS + t; }
        v4u zq[3], zk = zkn, zr = zrn; f32x4 tb[4];
#pragma unroll
        for (int jj = 0; jj < 3; ++jj) zq[jj] = zqn[jj];
#pragma unroll
        for (int q = 0; q < 4; ++q) tb[q] = tbn[q];
        asm volatile("" : "+v"(zq[0]), "+v"(zq[1]), "+v"(zq[2]), "+v"(zk), "+v"(zr), "+v"(tb[0]), "+v"(tb[1]), "+v"(tb[2]), "+v"(tb[3]) :: "memory");
        { const int rn = (r + NGW < R0) ? r + NGW : r; MN_LOAD(rn); }
        asm volatile("" ::: "memory");
        if (lat) {
            float q[24]; float ss = 0.f;
#pragma unroll
            for (int jj = 0; jj < 3; ++jj) { const v4u z = zq[jj];
#pragma unroll
                for (int e = 0; e < 8; ++e) { const float x = (e & 1) ? bfhi(z[e >> 1]) : bflo(z[e >> 1]); q[jj * 8 + e] = x; ss += x * x; } }
            const float rstd = 1.f / sqrtf(wave_sum(ss) * (1.f / 1536.f) + RMS_EPS);
#pragma unroll
            for (int jj = 0; jj < 3; ++jj) { v4u w; w.x = pk2(q[jj * 8 + 0] * rstd, q[jj * 8 + 1] * rstd); w.y = pk2(q[jj * 8 + 2] * rstd, q[jj * 8 + 3] * rstd); w.z = pk2(q[jj * 8 + 4] * rstd, q[jj * 8 + 5] * rstd); w.w = pk2(q[jj * 8 + 6] * rstd, q[jj * 8 + 7] * rstd);
                *(GAS v4u*)(QN + (size_t)r * 1536 + jj * 512 + F.lane * 8) = w; }
        }
        {
            const v4u z = zk; float kv[8]; float ss = 0.f;
#pragma unroll
            for (int e = 0; e < 8; ++e) { const float x = (e & 1) ? bfhi(z[e >> 1]) : bflo(z[e >> 1]); kv[e] = x; ss += x * x; }
            const float rstd = 1.f / sqrtf(wave_sum(ss) * (1.f / 512.f) + RMS_EPS);
            v4u w; w.x = pk2(kv[0] * rstd, kv[1] * rstd); w.y = pk2(kv[2] * rstd, kv[3] * rstd); w.z = pk2(kv[4] * rstd, kv[5] * rstd); w.w = pk2(kv[6] * rstd, kv[7] * rstd);
            *(GAS v4u*)(KVN + (size_t)kvrow * 512 + F.lane * 8) = w;
        }
        {
            const v4u z = zr; float x[8], px[8];
#pragma unroll
            for (int e = 0; e < 8; ++e) x[e] = (e & 1) ? bfhi(z[e >> 1]) : bflo(z[e >> 1]);
#pragma unroll
            for (int e = 0; e < 8; ++e) px[e] = dpp_mov<0x4E>(x[e]);
            float o[8];
            if (lat) { const bool second = (l & 2) != 0;
#pragma unroll
                for (int q = 0; q < 4; ++q) { const f32x4 t4 = tb[q];
                    o[2 * q] = second ? (x[2 * q] * t4.x + px[2 * q] * t4.y) : (x[2 * q] * t4.x - px[2 * q] * t4.y);
                    o[2 * q + 1] = second ? (x[2 * q + 1] * t4.z + px[2 * q + 1] * t4.w) : (x[2 * q + 1] * t4.z - px[2 * q + 1] * t4.w); } }
            else {
#pragma unroll
                for (int e = 0; e < 8; ++e) o[e] = x[e]; }
            if (F.lane < 8) { v4u w; w.x = pk2(o[0], o[1]); w.y = pk2(o[2], o[3]); w.z = pk2(o[4], o[5]); w.w = pk2(o[6], o[7]); *(GAS v4u*)(KPE + (size_t)kvrow * 64 + l * 8) = w; }
        }
    }
#undef MN_LOAD
}
namespace ml {
constexpr int L = 64, DVS = 32, QP = 528, VP = 80, PP = 144;
constexpr int CTB = 34 * QP;
constexpr int O_Q = 0, O_K = 33792, O_CT = 67584, O_V = O_CT + 2 * CTB, O_VW = O_V + 64 * VP, O_P = O_VW + 64 * VP, O_SC = O_P + 64 * PP;
constexpr int S_A = 0, S_M = 64, S_WI = 128, S_CL = 192, S_WG = 256, S_DEC = 320, SCB = 328;
static_assert(O_SC + 2 * SCB * 4 <= LDSCTL_OFF && O_CT + CTB + 48 * QP <= LDSCTL_OFF, "mlstm LDS map");
__device__ __forceinline__ float log_sigmoid(float x) { return fminf(x, 0.f) - __logf(1.f + __expf(-fabsf(x))); }
typedef short v4i16_t __attribute__((ext_vector_type(4)));
__device__ __forceinline__ s16x4 trr(const LAS unsigned char* p) { return __builtin_bit_cast(s16x4, __builtin_amdgcn_ds_read_tr16_b64_v4i16((LAS v4i16_t*)p)); }
__device__ __forceinline__ bf16x8 cat(s16x4 lo, s16x4 hi) { return (bf16x8){lo[0], lo[1], lo[2], lo[3], hi[0], hi[1], hi[2], hi[3]}; }
__device__ __forceinline__ unsigned cvtpk(float lo, float hi) { unsigned r; asm volatile("v_cvt_pk_bf16_f32 %0, %1, %2" : "=v"(r) : "v"(lo), "v"(hi)); return r; }
template <int CTRL, int ROWMASK> __device__ __forceinline__ float dpp_f(float old, float v) { return __uint_as_float((unsigned)__builtin_amdgcn_update_dpp((int)__float_as_uint(old), (int)__float_as_uint(v), CTRL, ROWMASK, 0xF, false)); }
__device__ __forceinline__ float scan_add64(float v) {
    v += dpp_f<0x111, 0xF>(0.f, v); v += dpp_f<0x112, 0xF>(0.f, v); v += dpp_f<0x114, 0xF>(0.f, v); v += dpp_f<0x118, 0xF>(0.f, v);
    v += dpp_f<0x142, 0xA>(0.f, v); v += dpp_f<0x143, 0xC>(0.f, v); return v;
}
__device__ __forceinline__ float scan_max64(float v) {
    const float ninf = -__builtin_inff();
    v = fmaxf(v, dpp_f<0x111, 0xF>(ninf, v)); v = fmaxf(v, dpp_f<0x112, 0xF>(ninf, v)); v = fmaxf(v, dpp_f<0x114, 0xF>(ninf, v)); v = fmaxf(v, dpp_f<0x118, 0xF>(ninf, v));
    v = fmaxf(v, dpp_f<0x142, 0xA>(ninf, v)); v = fmaxf(v, dpp_f<0x143, 0xC>(ninf, v)); return v;
}
__device__ __forceinline__ float rdlane63(float v) { return __uint_as_float((unsigned)__builtin_amdgcn_readlane((int)__float_as_uint(v), 63)); }
__device__ __forceinline__ int row_of(int step, int i, int dir, int bb) {
    const bool isctx = step < 4; const int T = isctx ? CTXL : SEQ, p = (isctx ? step : step - 4) * L + i, t = dir ? T - 1 - p : p;
    return (isctx ? NL + bb * CTXL : bb * SEQ) + t;
}

__device__ __forceinline__ void mlstm_task(Frame& F, const Args& A, int task) {
    const int dvs = task & 7, hh = (task >> 3) & 3, bb = (task >> 5) & 3, dir = task >> 7;
    LAS unsigned char* lds = F.lds;
    int tid = F.tid; asm volatile("" : "+v"(tid));
    const int lane = tid & 63, w = F.wave, fr = lane & 15, fq = lane >> 4;
    const bf16* QK = WSP(bf16, WS_QK); const bf16* PB = WSP(bf16, WS_PB); const float* GT = WSP(float, WS_GATES);
    bf16* HO = WSP(bf16, WS_HF) + (size_t)dir * R0 * 1024;
    __syncthreads();
    for (int i = tid; i < (2 * CTB) / 4; i += 512) ((LAS unsigned*)(lds + O_CT))[i] = 0u;
    for (int i = tid; i < (2 * 64 * VP) / 4; i += 512) ((LAS unsigned*)(lds + O_V))[i] = 0u;
    __syncthreads();
    if (tid < 64) *(LAS unsigned short*)(lds + O_V + tid * VP + 64) = (unsigned short)0x3F80u;
    f32x4 cacc[2][3];
#pragma unroll
    for (int b = 0; b < 2; ++b)
#pragma unroll
        for (int a = 0; a < 3; ++a) cacc[b][a] = (f32x4){0.f, 0.f, 0.f, 0.f};
    float m_prev = 0.f;
    v4u qn_[4], kn_[4], vn_ = (v4u){0u, 0u, 0u, 0u}; float lin = 0.f, fgn = 0.f;
#define ML_PREFETCH(st) do { if (w == 0) { const size_t gr_ = (size_t)row_of((st), lane, dir, bb) * 16 + dir * 8 + hh; lin = GT[gr_]; fgn = GT[gr_ + 4]; } \
        const size_t row_ = (size_t)row_of((st), tid >> 3, dir, bb); const bf16* qrow_ = QK + row_ * 2048 + hh * 256; \
        _Pragma("unroll") for (int j = 0; j < 4; ++j) { const int col_ = j * 64 + (tid & 7) * 8; qn_[j] = *(const GAS v4u*)(qrow_ + col_); kn_[j] = *(const GAS v4u*)(qrow_ + 1024 + col_); } \
        if (tid < 256) vn_ = *(const GAS v4u*)(PB + (size_t)row_of((st), tid >> 2, dir, bb) * PW + 2048 + hh * 256 + dvs * DVS + (tid & 3) * 8); } while (0)
#define ML_SCALARS(par) do { LAS float* sc_ = (LAS float*)(lds + O_SC) + (par) * SCB; \
        const float bcs = scan_add64(log_sigmoid(fgn)); const float a_ = lin - bcs; const float pm = scan_max64(a_); \
        const float M_ = fmaxf(m_prev, pm); const float Mc = rdlane63(M_), bl = rdlane63(bcs); \
        sc_[S_A + lane] = a_; sc_[S_M + lane] = M_; sc_[S_WI + lane] = __expf(m_prev - M_); sc_[S_CL + lane] = __expf(-bcs - M_); sc_[S_WG + lane] = __expf(a_ - Mc); \
        if (lane == 0) sc_[S_DEC] = __expf(m_prev - Mc); \
        m_prev = bl + Mc; } while (0)
#define ML_BAR() do { asm volatile("s_waitcnt lgkmcnt(0)" ::: "memory"); __builtin_amdgcn_s_barrier(); asm volatile("" ::: "memory"); } while (0)
    float cvv[32];
    ML_PREFETCH(0);
    if (w == 0) ML_SCALARS(0);
    int cur = 0;
    for (int step = 0; step < 68; ++step) {
        const LAS float* sc = (const LAS float*)(lds + O_SC) + (step & 1) * SCB;
        {
            const int i = tid >> 3;
#pragma unroll
            for (int j = 0; j < 4; ++j) { const int col = j * 64 + (tid & 7) * 8; *(LAS v4u*)(lds + O_Q + i * QP + col * 2) = qn_[j]; *(LAS v4u*)(lds + O_K + i * QP + col * 2) = kn_[j]; }
        }
        const v4u vcur = vn_;
        if (tid < 256) *(LAS v4u*)(lds + O_V + (tid >> 2) * VP + (tid & 3) * 16) = vcur;
        if (step + 1 < 68) ML_PREFETCH(step + 1);
        const MoeItem cvi = moe_item(F, A, (step * 256 + task) * 8 + w); cv_issue(cvv, cvi.src, 2048, cvi.k0, cvi.n0, lane);
        const MoeItem cvj = moe_item(F, A, MOE_ITEMS_SCAN + ((step < MOE_SCAN2_STEPS ? step : 0) * 256 + task) * 8 + w); float cvu[32]; if (step < MOE_SCAN2_STEPS) cv_issue(cvu, cvj.src, 2048, cvj.k0, cvj.n0, lane);
        ML_BAR();
        if (tid < 256) { const float wg = sc[S_WG + (tid >> 2)]; v4u ww;
#pragma unroll
            for (int e = 0; e < 4; ++e) ww[e] = cvtpk(bflo(vcur[e]) * wg, bfhi(vcur[e]) * wg);
            *(LAS v4u*)(lds + O_VW + (tid >> 2) * VP + (tid & 3) * 16) = ww;
            if ((tid & 3) == 0) *(LAS unsigned short*)(lds + O_VW + (tid >> 2) * VP + 64) = (unsigned short)f2bf(wg); }
        {
            const int t0 = 16 * (w >> 1), t = t0 + fr; const float Mt = sc[S_M + t];
            f32x4 acc[2] = {(f32x4){0.f, 0.f, 0.f, 0.f}, (f32x4){0.f, 0.f, 0.f, 0.f}};
#pragma unroll
            for (int kk = 0; kk < 8; ++kk) {
                const bf16x8 qf = *(const LAS bf16x8*)(lds + O_Q + (t0 + fr) * QP + (kk * 32 + 8 * fq) * 2);
#pragma unroll
                for (int ct = 0; ct < 2; ++ct) { const int s0 = 32 * (w & 1) + 16 * ct;
                    if (s0 <= t0) { const bf16x8 kf = *(const LAS bf16x8*)(lds + O_K + (s0 + fr) * QP + (kk * 32 + 8 * fq) * 2);
                        acc[ct] = __builtin_amdgcn_mfma_f32_16x16x32_bf16(kf, qf, acc[ct], 0, 0, 0); } }
            }
#pragma unroll
            for (int ct = 0; ct < 2; ++ct) { const int s0 = 32 * (w & 1) + 16 * ct, sb = s0 + 4 * fq;
                const f32x4 av = *(const LAS f32x4*)(sc + S_A + sb); float pv[4];
#pragma unroll
                for (int e = 0; e < 4; ++e) pv[e] = (sb + e <= t) ? acc[ct][e] * __expf(av[e] - Mt) : 0.f;
                v2u pw; pw.x = cvtpk(pv[0], pv[1]); pw.y = cvtpk(pv[2], pv[3]);
                *(LAS v2u*)(lds + O_P + t * PP + sb * 2) = pw; }
        }
        ML_BAR();
        {
            const int t0 = 16 * (w >> 1), d0 = 16 * (w & 1), t = t0 + fr;
            const LAS unsigned char* ct = lds + O_CT + cur * CTB;
            f32x4 aC = (f32x4){0.f, 0.f, 0.f, 0.f}, aV = aC, dC = aC, dV = aC;
#pragma unroll
            for (int kk = 0; kk < 8; ++kk) {
                const bf16x8 qf = *(const LAS bf16x8*)(lds + O_Q + (t0 + fr) * QP + (kk * 32 + 8 * fq) * 2);
                const bf16x8 cf = *(const LAS bf16x8*)(ct + (d0 + fr) * QP + (kk * 32 + 8 * fq) * 2);
                const bf16x8 nf = *(const LAS bf16x8*)(ct + (32 + fr) * QP + (kk * 32 + 8 * fq) * 2);
                aC = __builtin_amdgcn_mfma_f32_16x16x32_bf16(cf, qf, aC, 0, 0, 0);
                dC = __builtin_amdgcn_mfma_f32_16x16x32_bf16(nf, qf, dC, 0, 0, 0);
            }
#pragma unroll
            for (int kk = 0; kk < 2; ++kk) {
                const bf16x8 pf = *(const LAS bf16x8*)(lds + O_P + (t0 + fr) * PP + (kk * 32 + 8 * fq) * 2);
                const LAS unsigned char* vb = lds + O_V + (kk * 32 + 8 * fq + (fr >> 2)) * VP + (d0 + 4 * (fr & 3)) * 2;
                const LAS unsigned char* v1 = lds + O_V + (kk * 32 + 8 * fq + (fr >> 2)) * VP + (32 + 4 * (fr & 3)) * 2;
                const bf16x8 vf = cat(trr(vb), trr(vb + 4 * VP)), of = cat(trr(v1), trr(v1 + 4 * VP));
                aV = __builtin_amdgcn_mfma_f32_16x16x32_bf16(vf, pf, aV, 0, 0, 0);
                dV = __builtin_amdgcn_mfma_f32_16x16x32_bf16(of, pf, dV, 0, 0, 0);
            }
            const float wi = sc[S_WI + t];
            const float den = __shfl(wi * dC[0] + dV[0], fr);
            const float rinv = 1.f / fmaxf(fabsf(den), sc[S_CL + t]);
            f32x4 hv;
#pragma unroll
            for (int e = 0; e < 4; ++e) hv[e] = (wi * aC[e] + aV[e]) * rinv;
            { v2u hw; hw.x = cvtpk(hv[0], hv[1]); hw.y = cvtpk(hv[2], hv[3]); *(GAS v2u*)(HO + (size_t)row_of(step, t, dir, bb) * 1024 + hh * 256 + dvs * DVS + d0 + 4 * fq) = hw; }
            const float dec = sc[S_DEC];
#pragma unroll
            for (int b = 0; b < 2; ++b)
#pragma unroll
                for (int a = 0; a < 3; ++a) cacc[b][a] = cacc[b][a] * dec;
#pragma unroll
            for (int kk = 0; kk < 2; ++kk) {
                bf16x8 vf[3];
#pragma unroll
                for (int a = 0; a < 3; ++a) { const LAS unsigned char* vb = lds + O_VW + (kk * 32 + 8 * fq + (fr >> 2)) * VP + (16 * a + 4 * (fr & 3)) * 2; vf[a] = cat(trr(vb), trr(vb + 4 * VP)); }
#pragma unroll
                for (int b = 0; b < 2; ++b) { const LAS unsigned char* kb = lds + O_K + (kk * 32 + 8 * fq + (fr >> 2)) * QP + (32 * w + 16 * b + 4 * (fr & 3)) * 2; const bf16x8 kf = cat(trr(kb), trr(kb + 4 * QP));
#pragma unroll
                    for (int a = 0; a < 3; ++a) cacc[b][a] = __builtin_amdgcn_mfma_f32_16x16x32_bf16(kf, vf[a], cacc[b][a], 0, 0, 0); }
            }
            LAS unsigned char* cn = lds + O_CT + (cur ^ 1) * CTB;
#pragma unroll
            for (int b = 0; b < 2; ++b) { const int dk = 32 * w + 16 * b + 4 * fq;
#pragma unroll
                for (int a = 0; a < 2; ++a) { v2u pw; pw.x = cvtpk(cacc[b][a][0], cacc[b][a][1]); pw.y = cvtpk(cacc[b][a][2], cacc[b][a][3]); *(LAS v2u*)(cn + (16 * a + fr) * QP + dk * 2) = pw; }
                if (fr == 0) { v2u pw; pw.x = cvtpk(cacc[b][2][0], cacc[b][2][1]); pw.y = cvtpk(cacc[b][2][2], cacc[b][2][3]); *(LAS v2u*)(cn + 32 * QP + dk * 2) = pw; } }
            if (w == 0 && step + 1 < 68) ML_SCALARS((step + 1) & 1);
        }
        cv_finish(cvv, cvi.dst, 32, cvi.dr0, cvi.k0, nullptr, lane);
        if (step < MOE_SCAN2_STEPS) cv_finish(cvu, cvj.dst, 32, cvj.dr0, cvj.k0, nullptr, lane);
        ML_BAR();
        cur ^= 1;
    }
    __syncthreads();
#undef ML_BAR
#undef ML_SCALARS
#undef ML_PREFETCH
}
}

__device__ __forceinline__ unsigned block_excl_scan(Frame& F, const Args& A, unsigned v, LAS unsigned* wsum, unsigned& total) {
    unsigned x = v;
#pragma unroll
    for (int o = 1; o < 64; o <<= 1) { const unsigned y = __shfl_up(x, o); if (F.lane >= o) x += y; }
    __syncthreads();
    if (F.lane == 63) wsum[F.wave] = x;
    __syncthreads();
    unsigned base = 0, tot = 0;
#pragma unroll
    for (int q = 0; q < 8; ++q) { const unsigned s = wsum[q]; if (q < F.wave) base += s; tot += s; }
    total = tot;
    return base + x - v;
}
__device__ __forceinline__ void topk_problem(Frame& F, const Args& A, int prob, int slots, bool padl1 = false) {
    const bool isctx = prob >= 64; const int q = prob & 63, b = q >> 4, e = q & 15;
    const int T = isctx ? CTXL : SEQ, cap = isctx ? CAPC : CAPL, rbase = isctx ? NL + b * CTXL : b * SEQ, sbase = isctx ? 2048 + b * CAPC : b * CAPL;
    LAS unsigned* keys = (LAS unsigned*)F.lds;
    LAS unsigned* hist = keys + 4096;
    LAS unsigned* wsum = hist + 256;
    LAS unsigned* sel = wsum + 8;
    const float* AFF = WSP(float, WS_AFF); int* RIDX = WSP(int, WS_RIDX); float* RGATE = WSP(float, WS_RGATE); int* RSLOT = WSP(int, WS_RSLOT);
    __syncthreads();
    for (int i = F.tid; i < T; i += 512) keys[i] = __float_as_uint(AFF[(size_t)(rbase + i) * 16 + e]);
    unsigned prefix = 0u, kleft = (unsigned)cap;
    for (int pass = 0; pass < 4; ++pass) {
        const int shift = 24 - 8 * pass;
        if (F.tid < 256) hist[F.tid] = 0u;
        __syncthreads();
        for (int i = F.tid; i < T; i += 512) { const unsigned k = keys[i]; const bool match = (pass == 0) || ((k >> (shift + 8)) == prefix); if (match) __hip_atomic_fetch_add(&hist[(k >> shift) & 255u], 1u, __ATOMIC_RELAXED, __HIP_MEMORY_SCOPE_WORKGROUP); }
        __syncthreads();
        if (F.tid < 64) {
            unsigned c[4], s = 0u;
#pragma unroll
            for (int j = 0; j < 4; ++j) { c[j] = hist[255 - (F.lane * 4 + j)]; s += c[j]; }
            unsigned incl = s;
#pragma unroll
            for (int o = 1; o < 64; o <<= 1) { const unsigned y = __shfl_up(incl, o); if (F.lane >= o) incl += y; }
            const unsigned before = incl - s;
            if (before < kleft && incl >= kleft) {
                unsigned accb = before; bool found = false;
#pragma unroll
                for (int j = 0; j < 4; ++j) { if (!found) { if (accb + c[j] >= kleft) { sel[0] = (prefix << 8) | (unsigned)(255 - (F.lane * 4 + j)); sel[1] = kleft - accb; found = true; } else accb += c[j]; } }
            }
        }
        __syncthreads();
        prefix = sel[0]; kleft = sel[1];
        __syncthreads();
    }
    const unsigned thr = prefix;
    const int per = T / 512 > 0 ? T / 512 : 1; const int i0 = F.tid * per; const bool act = i0 < T;
    unsigned ngt = 0u, neq = 0u;
    for (int j = 0; j < per; ++j) if (act) { const unsigned k = keys[i0 + j]; ngt += (k > thr) ? 1u : 0u; neq += (k == thr) ? 1u : 0u; }
    unsigned tot_gt, tot_eq;
    unsigned pgt = block_excl_scan(F, A, ngt, wsum, tot_gt);
    unsigned peq = block_excl_scan(F, A, neq, wsum, tot_eq);
    for (int j = 0; j < per; ++j) if (act) {
        const int i = i0 + j; const unsigned k = keys[i]; int slot = -1;
        if (k > thr) { slot = (int)pgt; ++pgt; }
        else if (k == thr) { if (peq < kleft) slot = (int)(tot_gt + peq); ++peq; }
        RSLOT[(size_t)(rbase + i) * 16 + e] = (slot >= 0) ? sbase + slot : -1;
        if (slot >= 0) { RIDX[e * slots + sbase + slot] = rbase + i; RGATE[e * slots + sbase + slot] = __uint_as_float(k); }
    }
    if (isctx && b == 0 && F.tid < 128) { RIDX[e * slots + 2176 + F.tid] = e * 128 + F.tid; RGATE[e * slots + 2176 + F.tid] = 0.f; }
#ifdef EXP_L1_NINE
    if (!isctx && b == 0 && slots == 2304 && F.tid < 256 && padl1) { RIDX[e * slots + 2048 + F.tid] = e * 256 + F.tid; RGATE[e * slots + 2048 + F.tid] = 0.f; }
#endif
    __syncthreads();
}
namespace at {
constexpr int NW = 8, QBLK = 32, KVBLK = 64;
#ifndef NQR
#define NQR 10
#endif
constexpr float SCALE = 0.07216878364870322f;
constexpr float THR = 8.f;
constexpr int LDQ = 3072, LDK = 4096, LDP = 64, LDO = 2048;
constexpr int SHM_V = KVBLK * 128 * 2, SHM_K = KVBLK * 128 * 2, SHM_P = KVBLK * 64 * 2;
constexpr int O_V = 0, O_K = 3 * SHM_V, O_PE = O_K + 2 * SHM_K, O_WS = O_PE + 2 * SHM_P, O_QP = O_WS + NW * 64 * 4, SHM_ATTN = O_QP + NW * 6 * 1024;
#define KSWZ(row, colB) ((row) * 256 + ((colB) ^ (((row) & 7) << 4)))
#define PSWZ(row, colB) ((row) * 128 + ((colB) ^ ((((row) >> 1) & 7) << 4)))
#define SBAR() __builtin_amdgcn_sched_barrier(0)
__device__ __forceinline__ int crow(int r, int hi) { return (r & 3) + 8 * (r >> 2) + 4 * hi; }
__device__ __forceinline__ unsigned cvtpk(float lo, float hi) { unsigned r; asm volatile("v_cvt_pk_bf16_f32 %0, %1, %2" : "=v"(r) : "v"(lo), "v"(hi)); return r; }
__device__ __forceinline__ void partialSM(f32x16& p0, f32x16& p1, float& m_reg, float& mn, float& alpha) {
  constexpr float C = SCALE * 1.4426950408889634f;
  float pmax = p0[0];
#pragma unroll
  for (int r = 1; r < 16; ++r) pmax = fmaxf(pmax, p0[r]);
#pragma unroll
  for (int r = 0; r < 16; ++r) pmax = fmaxf(pmax, p1[r]);
  { auto rr = __builtin_amdgcn_permlane32_swap(__float_as_uint(pmax), __float_as_uint(pmax), false, false);
    pmax = fmaxf(__uint_as_float(rr[0]), __uint_as_float(rr[1])); }
  if (__builtin_expect(__all(pmax - m_reg <= THR / SCALE), 1)) { mn = m_reg; alpha = 1.f; }
  else { mn = fmaxf(m_reg, pmax); alpha = __builtin_amdgcn_exp2f((m_reg - mn) * C); m_reg = mn; }
  float mnC = -mn * C;
#pragma unroll
  for (int r = 0; r < 16; ++r) p0[r] = fmaf(p0[r], C, mnC);
#pragma unroll
  for (int r = 0; r < 16; ++r) p1[r] = fmaf(p1[r], C, mnC);
#pragma unroll
  for (int r = 0; r < 16; ++r) p0[r] = __builtin_amdgcn_exp2f(p0[r]);
}
__device__ __forceinline__ void finishSM(f32x16& p0, f32x16& p1, float alpha, float& l_reg, bf16x8& pa0, bf16x8& pa1, bf16x8& pa2, bf16x8& pa3) {
#pragma unroll
  for (int r = 0; r < 16; ++r) p1[r] = __builtin_amdgcn_exp2f(p1[r]);
  float ps = 0;
#pragma unroll
  for (int r = 0; r < 16; ++r) ps += p0[r];
#pragma unroll
  for (int r = 0; r < 16; ++r) ps += p1[r];
  { auto rr = __builtin_amdgcn_permlane32_swap(__float_as_uint(ps), __float_as_uint(ps), false, false);
    ps = __uint_as_float(rr[0]) + __uint_as_float(rr[1]); }
  l_reg = l_reg * alpha + ps;
#define PK4(P, BASE, OUT) do { unsigned a0 = cvtpk(P[BASE + 0], P[BASE + 1]), a1 = cvtpk(P[BASE + 2], P[BASE + 3]);   \
    unsigned b0 = cvtpk(P[BASE + 4], P[BASE + 5]), b1 = cvtpk(P[BASE + 6], P[BASE + 7]);                              \
    auto r0 = __builtin_amdgcn_permlane32_swap(a0, b0, false, false); auto r1 = __builtin_amdgcn_permlane32_swap(a1, b1, false, false); \
    v4u w = {r0[0], r1[0], r0[1], r1[1]}; OUT = *reinterpret_cast<bf16x8*>(&w); } while (0)
  PK4(p0, 0, pa0); PK4(p0, 8, pa1); PK4(p1, 0, pa2); PK4(p1, 8, pa3);
#undef PK4
}
__device__ __forceinline__ void qkt(f32x16& p0, f32x16& p1, const char* Ks, const char* Ps, const bf16x8* qr, const char* qp, int r32, int hi) {
  p0 = f32x16{}; p1 = f32x16{};
#pragma unroll
  for (int d0 = 0; d0 < 8; ++d0) { int cb = (d0 * 16 + hi * 8) * 2;
    bf16x8 b0 = *reinterpret_cast<const bf16x8*>(Ks + KSWZ(r32, cb));
    bf16x8 b1 = *reinterpret_cast<const bf16x8*>(Ks + KSWZ(32 + r32, cb));
    const bf16x8 qv = (d0 < NQR) ? qr[d0 < NQR ? d0 : 0] : *reinterpret_cast<const bf16x8*>(qp + (d0 - NQR < 0 ? 0 : d0 - NQR) * 1024);
    p0 = __builtin_amdgcn_mfma_f32_32x32x16_bf16(b0, qv, p0, 0, 0, 0);
    p1 = __builtin_amdgcn_mfma_f32_32x32x16_bf16(b1, qv, p1, 0, 0, 0); }
#pragma unroll
  for (int d0 = 0; d0 < 4; ++d0) { int cb = (d0 * 16 + hi * 8) * 2;
    bf16x8 b0 = *reinterpret_cast<const bf16x8*>(Ps + PSWZ(r32, cb));
    bf16x8 b1 = *reinterpret_cast<const bf16x8*>(Ps + PSWZ(32 + r32, cb));
    const bf16x8 qv = (8 + d0 < NQR) ? qr[8 + d0 < NQR ? 8 + d0 : 0] : *reinterpret_cast<const bf16x8*>(qp + (8 + d0 - NQR < 0 ? 0 : 8 + d0 - NQR) * 1024);
    p0 = __builtin_amdgcn_mfma_f32_32x32x16_bf16(b0, qv, p0, 0, 0, 0);
    p1 = __builtin_amdgcn_mfma_f32_32x32x16_bf16(b1, qv, p1, 0, 0, 0); }
}
__device__ __forceinline__ int v_st(int k, int c) { const int kk = (k & ~0xC) | ((k & 4) << 1) | ((k & 8) >> 1); return ((kk >> 3) * 4 + (c >> 5)) * 512 + ((kk & 7) * 32 + (c & 31)) * 2; }
__device__ __forceinline__ int v_rd_base(int lane) { return ((lane & 3) << 3) | (((lane >> 2) & 3) << 6) | (((lane >> 4) & 1) << 5) | (((lane >> 5) & 1) << 8); }
constexpr int v_rd_off(int d0, int ks, int half) { return d0 * 512 + ks * 4096 + half * 2048; }
template <int OFF> __device__ __forceinline__ s16x4 tr_read(int vb) {
  s16x4 r; asm volatile("ds_read_b64_tr_b16 %0, %1 offset:%2" : "=&v"(r) : "v"(vb), "i"(OFF) : "memory"); return r;
}
template <int D0> __device__ __forceinline__ void pv_one(f32x16& od, int vb, bf16x8 pa0, bf16x8 pa1, bf16x8 pa2, bf16x8 pa3) {
  const s16x4 l0 = tr_read<v_rd_off(D0, 0, 0)>(vb), h0 = tr_read<v_rd_off(D0, 0, 1)>(vb), l1 = tr_read<v_rd_off(D0, 1, 0)>(vb), h1 = tr_read<v_rd_off(D0, 1, 1)>(vb);
  const s16x4 l2 = tr_read<v_rd_off(D0, 2, 0)>(vb), h2 = tr_read<v_rd_off(D0, 2, 1)>(vb), l3 = tr_read<v_rd_off(D0, 3, 0)>(vb), h3 = tr_read<v_rd_off(D0, 3, 1)>(vb);
  asm volatile("s_waitcnt lgkmcnt(0)" ::: "memory"); SBAR();
#define PK(L, H) (bf16x8){L[0], L[1], L[2], L[3], H[0], H[1], H[2], H[3]}
  od = __builtin_amdgcn_mfma_f32_32x32x16_bf16(pa0, PK(l0, h0), od, 0, 0, 0);
  od = __builtin_amdgcn_mfma_f32_32x32x16_bf16(pa1, PK(l1, h1), od, 0, 0, 0);
  od = __builtin_amdgcn_mfma_f32_32x32x16_bf16(pa2, PK(l2, h2), od, 0, 0, 0);
  od = __builtin_amdgcn_mfma_f32_32x32x16_bf16(pa3, PK(l3, h3), od, 0, 0, 0);
#undef PK
}
__device__ __forceinline__ void pv_d0(f32x16* o, int vb, bf16x8 pa0, bf16x8 pa1, bf16x8 pa2, bf16x8 pa3) {
  pv_one<0>(o[0], vb, pa0, pa1, pa2, pa3); pv_one<1>(o[1], vb, pa0, pa1, pa2, pa3); pv_one<2>(o[2], vb, pa0, pa1, pa2, pa3); pv_one<3>(o[3], vb, pa0, pa1, pa2, pa3);
}
__device__ __forceinline__ void attn_unit(const bf16* Qb, const bf16* Kh, const bf16* Vh, const bf16* Kp, bf16* Ob, int seq, char* lds) {
  int tid = threadIdx.x; asm volatile("" : "+v"(tid));
  const int wid = tid >> 6, lane = tid & 63, r32 = lane & 31, hi = lane >> 5;
  char* V_lds = lds + O_V; char* K_lds = lds + O_K; char* P_lds = lds + O_PE;
  float* ws = (float*)(lds + O_WS) + wid * 64; float* li_l = ws; float* al_l = ws + 32;
  float m_reg = -1e30f, l_reg = 0; f32x16 o[4] = {}; bf16x8 qr[NQR];
  const bf16* Qw = Qb + (long)(wid * QBLK + r32) * LDQ + hi * 8;
#pragma unroll
  for (int d0 = 0; d0 < NQR; ++d0) qr[d0] = *reinterpret_cast<const bf16x8*>(Qw + d0 * 16);
  char* qp = lds + O_QP + wid * 6144 + lane * 16;
#pragma unroll
  for (int f = NQR; f < 12; ++f) *reinterpret_cast<bf16x8*>(qp + (f - NQR) * 1024) = *reinterpret_cast<const bf16x8*>(Qw + f * 16);
  const int vb0 = (int)(uintptr_t)V_lds + v_rd_base(lane);
  const int widu = __builtin_amdgcn_readfirstlane(tid >> 6);
  unsigned gk[2], gv[2], gp;
#pragma unroll
  for (int i = 0; i < 2; ++i) { const int q = widu * 2 + i;
    { const int row = 4 * q + (lane >> 4), pch = lane & 15; gk[i] = (unsigned)(row * LDK + ((pch ^ (row & 7)) * 8)); }
    { const int jch = q * 64 + lane, blk = jch >> 5, ch = jch & 31, kk = (blk >> 2) * 8 + (ch >> 2), c = (blk & 3) * 32 + (ch & 3) * 8;
      const int k = (kk & ~0xC) | ((kk & 4) << 1) | ((kk & 8) >> 1); gv[i] = (unsigned)(k * LDK + c); } }
  { const int jch = widu * 64 + lane, row = jch >> 3, pch = jch & 7; gp = (unsigned)(row * LDP + ((pch ^ ((row >> 1) & 7)) * 8)); }
  typedef __attribute__((address_space(3))) unsigned las_u32;
  const unsigned ldsK = (unsigned)(uintptr_t)K_lds + widu * 2048u, ldsV = (unsigned)(uintptr_t)V_lds + widu * 2048u, ldsP = (unsigned)(uintptr_t)P_lds + widu * 1024u;
#define DMA_KP(t, b) do { const bf16* Kt_ = Kh + (long)(t) * KVBLK * LDK; const bf16* Pt_ = Kp + (long)(t) * KVBLK * LDP; \
    __builtin_amdgcn_global_load_lds((const unsigned*)(Kt_ + gk[0]), (las_u32*)(ldsK + (b) * SHM_K), 16, 0, 0); \
    __builtin_amdgcn_global_load_lds((const unsigned*)(Kt_ + gk[1]), (las_u32*)(ldsK + (b) * SHM_K + 1024u), 16, 0, 0); \
    __builtin_amdgcn_global_load_lds((const unsigned*)(Pt_ + gp), (las_u32*)(ldsP + (b) * SHM_P), 16, 0, 0); } while (0)
#define DMA_V(t, b) do { const bf16* Vt_ = Vh + (long)(t) * KVBLK * LDK; \
    __builtin_amdgcn_global_load_lds((const unsigned*)(Vt_ + gv[0]), (las_u32*)(ldsV + (b) * SHM_V), 16, 0, 0); \
    __builtin_amdgcn_global_load_lds((const unsigned*)(Vt_ + gv[1]), (las_u32*)(ldsV + (b) * SHM_V + 1024u), 16, 0, 0); } while (0)
#define DWAIT() asm volatile("s_waitcnt vmcnt(0)" ::: "memory")
#define RESC(a) do { if (__any((a) < 1.f)) { if (hi == 0) al_l[r32] = (a); asm volatile("s_waitcnt lgkmcnt(0)" ::: "memory"); \
    _Pragma("unroll") for (int d = 0; d < 4; ++d) _Pragma("unroll") for (int r = 0; r < 16; ++r) o[d][r] *= al_l[crow(r, hi)]; } } while (0)
  f32x16 pA0, pA1, pB0, pB1; float mnA, mnB, alA, alB; bf16x8 pa0, pa1, pa2, pa3; const int NT = seq / KVBLK;
#define DWAIT2() asm volatile("s_waitcnt vmcnt(2)" ::: "memory")
#define VNEXT(x) ((x) == 2 ? 0 : (x) + 1)
  DMA_KP(0, 0); DMA_V(0, 0); DMA_KP(1, 1); DMA_V(1, 1); DWAIT(); __syncthreads();
  qkt(pA0, pA1, K_lds, P_lds, qr, qp, r32, hi); partialSM(pA0, pA1, m_reg, mnA, alA);
  __syncthreads();
  int vr = 0, vw = 2;
  for (int j = 1; j + 1 < NT; j += 2) {
    DMA_KP(j + 1, 0); DMA_V(j + 1, vw);
    SBAR(); qkt(pB0, pB1, K_lds + SHM_K, P_lds + SHM_P, qr, qp, r32, hi);
    finishSM(pA0, pA1, alA, l_reg, pa0, pa1, pa2, pa3); SBAR();
    pv_d0(o, vb0 + vr * (int)SHM_V, pa0, pa1, pa2, pa3); partialSM(pB0, pB1, m_reg, mnB, alB);
    RESC(alB); DWAIT2(); __syncthreads();
    vr = VNEXT(vr); vw = VNEXT(vw);
    DMA_KP(j + 2 < NT ? j + 2 : NT - 1, 1); DMA_V(j + 2 < NT ? j + 2 : NT - 1, vw);
    SBAR(); qkt(pA0, pA1, K_lds, P_lds, qr, qp, r32, hi);
    finishSM(pB0, pB1, alB, l_reg, pa0, pa1, pa2, pa3); SBAR();
    pv_d0(o, vb0 + vr * (int)SHM_V, pa0, pa1, pa2, pa3); partialSM(pA0, pA1, m_reg, mnA, alA);
    RESC(alA); DWAIT2(); __syncthreads();
    vr = VNEXT(vr); vw = VNEXT(vw);
  }
  SBAR(); qkt(pB0, pB1, K_lds + SHM_K, P_lds + SHM_P, qr, qp, r32, hi);
  finishSM(pA0, pA1, alA, l_reg, pa0, pa1, pa2, pa3); SBAR();
  pv_d0(o, vb0 + vr * (int)SHM_V, pa0, pa1, pa2, pa3); partialSM(pB0, pB1, m_reg, mnB, alB);
  RESC(alB); DWAIT(); __syncthreads();
  vr = VNEXT(vr);
  finishSM(pB0, pB1, alB, l_reg, pa0, pa1, pa2, pa3); SBAR();
  pv_d0(o, vb0 + vr * (int)SHM_V, pa0, pa1, pa2, pa3);
#undef DWAIT2
#undef VNEXT
  if (hi == 0) li_l[r32] = l_reg; asm volatile("s_waitcnt lgkmcnt(0)" ::: "memory");
  float rli[16];
#pragma unroll
  for (int r = 0; r < 16; ++r) rli[r] = __builtin_amdgcn_rcpf(li_l[crow(r, hi)]);
  bf16* Ow = Ob + (long)(wid * QBLK) * LDO;
#pragma unroll
  for (int r = 0; r < 16; ++r) { int orow = crow(r, hi);
#pragma unroll
    for (int d0 = 0; d0 < 4; ++d0) Ow[(long)orow * LDO + d0 * 32 + r32] = (bf16)f2bf(o[d0][r] * rli[r]); }
  __syncthreads();
#undef DMA_KP
#undef DMA_V
#undef DWAIT
#undef RESC
}
#undef KSWZ
#undef PSWZ
#undef SBAR
}
#ifndef DBG_SKIP
#define DBG_SKIP 0
#endif
__global__ void __launch_bounds__(NWAVES * 64, 2) fwd_kernel(Args args) {
    const Args& A = args;
    extern __shared__ __attribute__((aligned(16))) unsigned char lds[];
    Frame F;
    F.lds = (LAS unsigned char*)lds;
    F.MISC = (volatile LAS unsigned*)(F.lds + MISC_OFF);
    F.tid = threadIdx.x; F.lane = F.tid & 63; F.wave = __builtin_amdgcn_readfirstlane(F.tid >> 6);
    F.G = gridDim.x; { const int bx = blockIdx.x; F.vcu = (F.G % 8 == 0) ? (bx % 8) * (F.G / 8) + bx / 8 : bx; }
    F.ws = args.ws; F.ctl = (gu32*)(args.ws + WS_CTL); F.out = args.out;
    for (int u = F.tid; u < (LDS_BYTES - LDSCTL_OFF) / 4; u += NWAVES * 64) ((LAS unsigned*)(F.lds + LDSCTL_OFF))[u] = 0u;
    __syncthreads();
    XcdBarrier bar = xcd_barrier_post((unsigned*)(F.ctl + CW_BAR), F.MISC + 8);
    const int lo = args.ph_lo, hi = args.ph_hi;
#ifndef PH_MASK
#define PH_MASK 0xffffffffu
#endif
#define IN(k) ((((PH_MASK) >> (k)) & 1u) && lo <= (k) && (k) < hi)
#define SEAM(k) do { if (IN(k) && IN((k) + 1)) xcd_barrier(bar); } while (0)
#ifndef DUP_MASK
#define DUP_MASK 0u
#endif
#define REP(k) for (int rep_ = 0; rep_ < ((((DUP_MASK) >> (k)) & 1u) ? 2 : 1); ++rep_)
    const int bx = (int)blockIdx.x;

    if (IN(0)) REP(0) { p0_prologue(F, A); } SEAM(0);
    if (IN(1)) REP(1) { ph_mod0(F, A); } SEAM(1);
    if (IN(2)) REP(2) {
        pg8::Gemm g{WSP(bf16, WS_H), WSP(bf16, WS_WIN0), 2048, 2048, 2048}; pg8::DenseOrder S; S.init(R0 / 256, PW / 256 + 1, F.G, bx);
        pg8::EpiG1 E{WSP(bf16, WS_PB), PW, WSP(float, WS_GATES), A.in[11]};
        pg8::gemm_phase<pg8::EpiG1, pg8::DenseOrder>(F.lds, g, S, E);
    } SEAM(2);
    if (IN(3)) REP(3) { ph_conv_pool(F, A); } SEAM(3);
    if (IN(4)) REP(4) {
#ifndef NO_MLSTM
        for (int tk = F.vcu; tk < 256; tk += F.G) ml::mlstm_task(F, A, tk);
#endif
        pg8::Gemm g{WSP(bf16, WS_PU), WSP(bf16, WS_WPOOL), 1024, 256, 256}; pg8::PoolOrder S; S.init(R0 / 256, F.G, F.vcu);
        pg8::EpiBf16 E{WSP(bf16, WS_A2), 2048, 1024, 256, A.in[14] - 1024, nullptr};
#ifndef NO_POOLG
        pg8::gemm_phase<pg8::EpiBf16, pg8::PoolOrder>(F.lds, g, S, E);
#endif
    } SEAM(4);
    if (IN(5)) REP(5) { ph_readout(F, A); } SEAM(5);
    if (IN(6)) REP(6) {
        pg8::Gemm g{WSP(bf16, WS_A2), WSP(bf16, WS_WOUT0), 2048, 2048, 2048}; pg8::SplitOrder S; S.init(64, R0 / 256 - 64, 8, F.G, bx);
        pg8::EpiSig<pg8::EpiBf16> E{{WSP(bf16, WS_Y), 2048, 0, 0, nullptr, nullptr}, (unsigned*)(F.ctl + CW_RDY), (LAS unsigned*)(F.lds + MISC_OFF + 64)};
        pg8::gemm_phase<pg8::EpiSig<pg8::EpiBf16>, pg8::SplitOrder>(F.lds, g, S, E);
    }
    if (IN(7)) REP(7) {
        unsigned* rdy = (unsigned*)(F.ctl + CW_RDY);
        int first = F.vcu * NWAVES + F.wave, step = F.G * NWAVES, rend = R0, blo = 0, bhi = R0 / 256 - 1;
        if (F.G == 256) { if (bx >= 32) { first = (bx - 32) * NWAVES + F.wave; step = 224 * NWAVES; rend = 224 * 72; bhi = 62; } else { first = 224 * 72 + bx * NWAVES + F.wave; step = 32 * NWAVES; blo = 63; } }
        ph_post1(F, A, 0, first, step, rend, rdy, 8u, blo, bhi);
    } SEAM(7);
    if (IN(8)) REP(8) { for (int p = F.vcu; p < 128; p += F.G) topk_problem(F, A, p, SLOTS0); } SEAM(8);
    if (IN(9)) REP(9) {
        pg8::Gemm g{WSP(bf16, WS_H), WSP(bf16, WS_WM13), 2048, 2048, 2048}; pg8::MoeOrder<true> S; S.init(SLOTS0 / 256, 16, 4096, WSP(int, WS_RIDX), F.G, bx);
        pg8::EpiSwiGLU E{WSP(bf16, WS_ACT), 2048};
        pg8::gemm_phase<pg8::EpiSwiGLU, pg8::MoeOrder<true>>(F.lds, g, S, E);
    } SEAM(9);
    if (IN(10)) REP(10) {
        pg8::Gemm g{WSP(bf16, WS_ACT), WSP(bf16, WS_WM2), 2048, 2048, 2048}; pg8::MoeOrder<false> S; S.init(SLOTS0 / 256, 8, 2048, nullptr, F.G, bx);
        pg8::EpiBf16 E{WSP(bf16, WS_YS), 2048, 0, 0, nullptr, nullptr};
        pg8::gemm_phase<pg8::EpiBf16, pg8::MoeOrder<false>>(F.lds, g, S, E);
    } SEAM(10);
    if (IN(11)) REP(11) { ph_combine(F, A, 0, R0, SLOTS0); } SEAM(11);
    if (IN(12)) REP(12) {
        pg8::Gemm g{WSP(bf16, WS_H), WSP(bf16, WS_WMIN), 2048, 2048, 2048}; pg8::MlaInOrder S; S.init(F.G, bx);
        pg8::EpiBf16 E{WSP(bf16, WS_PL), PLW, 0, 0, nullptr, nullptr};
        pg8::gemm_phase<pg8::EpiBf16, pg8::MlaInOrder>(F.lds, g, S, E);
    } SEAM(12);
    if (IN(13)) REP(13) { ph_mla_norm(F, A); } SEAM(13);
    if (IN(14)) REP(14) {
        { pg8::Gemm g{WSP(bf16, WS_QN), WSP(bf16, WS_WUQ), 1536, 1536, 1536}; pg8::DenseOrder S; S.init(NL / 256, 12, F.G, bx);
          pg8::EpiRopeQ E{WSP(bf16, WS_QF), 3072, WSP(float, WS_ROPE)};
          pg8::gemm_phase<pg8::EpiRopeQ, pg8::DenseOrder>(F.lds, g, S, E); }
        { pg8::Gemm g{WSP(bf16, WS_KVN), WSP(bf16, WS_WUKV), 512, 512, 512}; pg8::DenseOrder S; S.init(R0 / 256, 16, F.G, bx);
          pg8::EpiBf16 E{WSP(bf16, WS_KV), 4096, 0, 0, nullptr, nullptr};
          pg8::gemm_phase<pg8::EpiBf16, pg8::DenseOrder>(F.lds, g, S, E); }
    } SEAM(14);
    if (IN(16)) REP(16) {
        for (int id = F.vcu; id < NB * AH * 16; id += F.G) {
            const int bh = id >> 4, qb = id & 15, b = bh >> 4, h = bh & 15;
            const bf16* Qb = WSP(bf16, WS_QF) + (size_t)(b * SEQ + qb * 256) * 3072 + h * 192;
            const bf16* Kh = WSP(bf16, WS_KV) + (size_t)(b * KVS) * 4096 + h * 256;
            const bf16* Kp = WSP(bf16, WS_KPE) + (size_t)(b * KVS) * 64;
            bf16* Ob = WSP(bf16, WS_O) + (size_t)(b * SEQ + qb * 256) * 2048 + h * 128;
            at::attn_unit(Qb, Kh, Kh + 128, Kp, Ob, KVS, (char*)lds);
        }
    } SEAM(16);
    if (IN(17)) REP(17) {
        pg8::Gemm g{WSP(bf16, WS_O), WSP(bf16, WS_WO), 2048, 2048, 2048}; pg8::DenseOrder S; S.init(NL / 256, 8, F.G, bx);
        pg8::EpiBf16 E{WSP(bf16, WS_Y), 2048, 0, 0, nullptr, nullptr};
        pg8::gemm_phase<pg8::EpiBf16, pg8::DenseOrder>(F.lds, g, S, E);
    } SEAM(17);
    if (IN(18)) REP(18) { ph_post1(F, A, 1, F.vcu * NWAVES + F.wave, F.G * NWAVES, NL, nullptr, 0u, 0, -1); } SEAM(18);
    if (IN(19)) REP(19) { for (int p = F.vcu; p < 64; p += F.G) topk_problem(F, A, p, SLOTS1); } SEAM(19);
    if (IN(20)) REP(20) {
        pg8::Gemm g{WSP(bf16, WS_H), WSP(bf16, WS_WM13) + (size_t)16 * 4096 * 2048, 2048, 2048, 2048}; pg8::MoeOrder<true> S; S.init(SLOTS1 / 256, 16, 4096, WSP(int, WS_RIDX), F.G, bx);
        pg8::EpiSwiGLU E{WSP(bf16, WS_ACT), 2048};
        pg8::gemm_phase<pg8::EpiSwiGLU, pg8::MoeOrder<true>>(F.lds, g, S, E);
    } SEAM(20);
    if (IN(21)) REP(21) {
        pg8::Gemm g{WSP(bf16, WS_ACT), WSP(bf16, WS_WM2) + (size_t)16 * 2048 * 2048, 2048, 2048, 2048}; pg8::MoeOrder<false> S; S.init(SLOTS1 / 256, 8, 2048, nullptr, F.G, bx);
        pg8::EpiBf16 E{WSP(bf16, WS_YS), 2048, 0, 0, nullptr, nullptr};
        pg8::gemm_phase<pg8::EpiBf16, pg8::MoeOrder<false>>(F.lds, g, S, E);
    } SEAM(21);
    if (IN(22)) REP(22) {
        ph_combine(F, A, 1, NL, SLOTS1);
        if (xb_ld((unsigned*)(F.ctl + CW_BAR) + XB_TMO) != 0u) {
            const int gw = F.vcu * NWAVES + F.wave, NGW = F.G * NWAVES; const float qn = __builtin_nanf("");
            for (int r = gw; r < NL; r += NGW) F.out[(size_t)r * DM + F.lane] = qn;
        }
    }
#undef IN
#undef SEAM
}
constexpr int N_PHASES = 23;

#ifndef MK_PER_PHASE
#define MK_PER_PHASE 0
#endif
extern "C" void kernel_launch(void* const* d_in, const int* in_sizes, int n_in, void* d_out, int out_size, void* d_ws, size_t ws_size, hipStream_t stream) {
    static int grid = 0;
    if (grid == 0) {
        if (n_in != 26 || in_sizes[0] != NL * DM || out_size != NL * DM || ws_size < WS_END) {
            fprintf(stderr, "kernel_launch: shape mismatch: n_in %d in0 %d out %d ws %zu (need %zu); nothing launched\n", n_in, n_in > 0 ? in_sizes[0] : -1, out_size, ws_size, (size_t)WS_END); grid = -1; return; }
        int dev = 0, cus = 0, per_cu = 0;
        if (hipGetDevice(&dev) != hipSuccess || hipDeviceGetAttribute(&cus, hipDeviceAttributeMultiprocessorCount, dev) != hipSuccess) { grid = -1; return; }
        if (hipFuncSetAttribute((const void*)fwd_kernel, hipFuncAttributeMaxDynamicSharedMemorySize, LDS_BYTES) != hipSuccess) { fprintf(stderr, "kernel_launch: hipFuncSetAttribute failed\n"); grid = -1; return; }
        if (hipOccupancyMaxActiveBlocksPerMultiprocessor(&per_cu, (const void*)fwd_kernel, NWAVES * 64, LDS_BYTES) != hipSuccess || per_cu < 1)
            fprintf(stderr, "kernel_launch: note: occupancy query reports %d workgroups per CU\n", per_cu);
        (void)hipGetLastError();
        grid = cus;
    }
    if (grid < 0) return;
    if (hipMemsetAsync((char*)d_ws + WS_CTL, 0, CTL_ZERO_BYTES, stream) != hipSuccess) { fprintf(stderr, "kernel_launch: memset failed\n"); return; }
    Args a{};
    for (int i = 0; i < 26; ++i) a.in[i] = (const float*)d_in[i];
    a.out = (float*)d_out; a.ws = (unsigned char*)d_ws;
#if MK_PER_PHASE
    for (int p = 0; p < N_PHASES; ++p) { a.ph_lo = p; a.ph_hi = p + 1; hipLaunchKernelGGL(fwd_kernel, dim3(grid), dim3(NWAVES * 64), LDS_BYTES, stream, a); }
#else
    a.ph_lo = 0; a.ph_hi = N_PHASES;
    hipLaunchKernelGGL(fwd_kernel, dim3(grid), dim3(NWAVES * 64), LDS_BYTES, stream, a);
#endif
    const hipError_t le = hipPeekAtLastError();
    if (le != hipSuccess) fprintf(stderr, "kernel_launch: launch failed: %s\n", hipGetErrorName(le));
}
```
